# Optimizing an MI355X kernel written in HIP

```python
import math
import jax, jax.numpy as jnp
from jax import lax
import numpy as np

D_MODEL = 1024
BATCH = 2
SEQ = 8192
DEPTH = 2

GRID_W = 64
CTX_LEN = 256
N_HEADS = 8
N_KV_HEADS = 2
HEAD_DIM = 64
GROUP = N_HEADS // N_KV_HEADS
ATTN_W = N_HEADS * HEAD_DIM
KV_W = N_KV_HEADS * HEAD_DIM
CONV_W = D_MODEL // 2
CONV_K = 3
WINDOW = 128
BLOCK = 128
D_FF = 2816
ROPE_THETA = 10000.0
EPS = 1e-6
N_MOD = 9
NEG_INF = -1e30
PROJ_SIZES = (ATTN_W, KV_W, KV_W, CONV_W, CONV_W, CONV_W, D_MODEL, D_MODEL)
PROJ_W = ATTN_W + 2 * KV_W + 3 * CONV_W + 2 * D_MODEL

kernel_name = 'hybrid_dit_gqa_sink_shortconv_macaron'


def _split_points(sizes):
    return [int(s) for s in np.cumsum(sizes)[:-1]]


def rmsnorm(x, w):
    xf = x.astype(jnp.float32)
    y = xf * lax.rsqrt(jnp.mean(xf * xf, axis=-1, keepdims=True) + EPS)
    return (y * w.astype(jnp.float32)).astype(x.dtype)


def modulate(h, shift, scale):
    return h * (1 + scale) + shift


def swiglu(h, wi, wo):
    a, g = jnp.split(h @ wi, 2, axis=-1)
    return (jax.nn.silu(g) * a) @ wo


def axial_rope_tables(n_rows):
    row = jnp.broadcast_to(jnp.arange(n_rows)[:, None], (n_rows, GRID_W)).reshape(-1)
    col = jnp.broadcast_to(jnp.arange(GRID_W)[None, :], (n_rows, GRID_W)).reshape(-1)
    n_freq = HEAD_DIM // 4
    inv = ROPE_THETA ** (-jnp.arange(n_freq, dtype=jnp.float32) / n_freq)
    ang_r = row.astype(jnp.float32)[:, None] * inv
    ang_c = col.astype(jnp.float32)[:, None] * inv
    return (jnp.cos(ang_r)[:, None, :], jnp.sin(ang_r)[:, None, :],
            jnp.cos(ang_c)[:, None, :], jnp.sin(ang_c)[:, None, :])


def _rot_half(y, cos, sin):
    y1, y2 = jnp.split(y, 2, axis=-1)
    return jnp.concatenate([y1 * cos - y2 * sin, y2 * cos + y1 * sin], axis=-1)


def apply_axial_rope(t, tables):
    cos_r, sin_r, cos_c, sin_c = tables
    tr, tc = jnp.split(t.astype(jnp.float32), 2, axis=-1)
    out = jnp.concatenate([_rot_half(tr, cos_r, sin_r), _rot_half(tc, cos_c, sin_c)], axis=-1)
    return out.astype(t.dtype)


def _sink_logits(sink, lead_shape, n_q):
    s = sink.astype(jnp.float32).reshape(N_KV_HEADS, GROUP)[:, :, None, None]
    return jnp.broadcast_to(s, tuple(lead_shape) + (N_KV_HEADS, GROUP, n_q, 1))


def windowed_attention_with_context(q, k, v, kc, vc, sink):
    B, S = q.shape[0], q.shape[1]
    nb = S // BLOCK
    L = kc.shape[1]
    scale = HEAD_DIM ** -0.5
    qb = q.reshape(B, nb, BLOCK, N_KV_HEADS, GROUP, HEAD_DIM)
    pad = ((0, 0), (BLOCK, BLOCK), (0, 0), (0, 0))
    kp = jnp.pad(k, pad).reshape(B, nb + 2, BLOCK, N_KV_HEADS, HEAD_DIM)
    vp = jnp.pad(v, pad).reshape(B, nb + 2, BLOCK, N_KV_HEADS, HEAD_DIM)
    kw = jnp.concatenate([kp[:, :-2], kp[:, 1:-1], kp[:, 2:]], axis=2)
    vw = jnp.concatenate([vp[:, :-2], vp[:, 1:-1], vp[:, 2:]], axis=2)
    s_loc = jnp.einsum('bnqkgd,bnjkd->bnkgqj', qb, kw, preferred_element_type=jnp.float32) * scale
    s_ctx = jnp.einsum('bnqkgd,bjkd->bnkgqj', qb, kc, preferred_element_type=jnp.float32) * scale
    blk = jnp.arange(nb)[:, None, None]
    qpos = blk * BLOCK + jnp.arange(BLOCK)[None, :, None]
    kpos = (blk - 1) * BLOCK + jnp.arange(3 * BLOCK)[None, None, :]
    valid = (jnp.abs(kpos - qpos) <= WINDOW) & (kpos >= 0) & (kpos < S)
    s_loc = jnp.where(valid[None, :, None, None], s_loc, NEG_INF)
    logits = jnp.concatenate([s_ctx, s_loc, _sink_logits(sink, (B, nb), BLOCK)], axis=-1)
    p = jax.nn.softmax(logits, axis=-1).astype(v.dtype)
    p_ctx, p_loc = p[..., :L], p[..., L:L + 3 * BLOCK]
    o = (jnp.einsum('bnkgqj,bjkd->bnqkgd', p_ctx, vc)
         + jnp.einsum('bnkgqj,bnjkd->bnqkgd', p_loc, vw))
    return o.reshape(B, S, ATTN_W)


def context_attention(qc, kc, vc, sink):
    B, L = qc.shape[0], qc.shape[1]
    qg = qc.reshape(B, L, N_KV_HEADS, GROUP, HEAD_DIM)
    s = jnp.einsum('bqkgd,bjkd->bkgqj', qg, kc, preferred_element_type=jnp.float32) * (HEAD_DIM ** -0.5)
    logits = jnp.concatenate([s, _sink_logits(sink, (B,), L)], axis=-1)
    p = jax.nn.softmax(logits, axis=-1)[..., :L].astype(vc.dtype)
    return jnp.einsum('bkgqj,bjkd->bqkgd', p, vc).reshape(B, L, ATTN_W)


def short_conv(u, w):
    up = jnp.pad(u, ((0, 0), (1, 1), (0, 0)))
    return up[:, :-2] * w[0] + up[:, 1:-1] * w[1] + up[:, 2:] * w[2]


def gated_merge(o_attn, y_conv, ga, gb, w_oa, w_ob, w_out):
    m = jax.nn.sigmoid(ga) * (o_attn @ w_oa) + jax.nn.sigmoid(gb) * (y_conv @ w_ob)
    return m @ w_out


def trunk_layer(x, xc, c_act, cc_act, tables, w_ada, b_ada, norm_w, ffn1_wi, ffn1_wo, w_in,
                conv_w, sink, w_oa, w_ob, w_out, ffn2_wi, ffn2_wo, last):
    B, S = x.shape[0], x.shape[1]
    L = xc.shape[1]
    mod = (c_act @ w_ada + b_ada).reshape(B, N_MOD, 1, D_MODEL)
    modc = (cc_act @ w_ada + b_ada).reshape(N_MOD, D_MODEL)
    x = x + 0.5 * mod[:, 2] * swiglu(modulate(rmsnorm(x, norm_w[0]), mod[:, 0], mod[:, 1]), ffn1_wi, ffn1_wo)
    xc = xc + 0.5 * modc[2] * swiglu(modulate(rmsnorm(xc, norm_w[0]), modc[0], modc[1]), ffn1_wi, ffn1_wo)
    splits = _split_points(PROJ_SIZES)
    h = modulate(rmsnorm(x, norm_w[1]), mod[:, 3], mod[:, 4])
    hc = modulate(rmsnorm(xc, norm_w[1]), modc[3], modc[4])
    zq, zk, zv, zb, zc, zu, zga, zgb = jnp.split(h @ w_in, splits, axis=-1)
    if last:
        ck, cv = jnp.split(hc @ w_in[:, ATTN_W:ATTN_W + 2 * KV_W], 2, axis=-1)
    else:
        cq, ck, cv, cb, cc, cu, cga, cgb = jnp.split(hc @ w_in, splits, axis=-1)
    kc = ck.reshape(B, L, N_KV_HEADS, HEAD_DIM)
    vc = cv.reshape(B, L, N_KV_HEADS, HEAD_DIM)
    q = apply_axial_rope(zq.reshape(B, S, N_HEADS, HEAD_DIM), tables)
    k = apply_axial_rope(zk.reshape(B, S, N_KV_HEADS, HEAD_DIM), tables)
    v = zv.reshape(B, S, N_KV_HEADS, HEAD_DIM)
    o_attn = windowed_attention_with_context(q, k, v, kc, vc, sink)
    y_conv = zb * short_conv(zc * zu, conv_w)
    x = x + mod[:, 5] * gated_merge(o_attn, y_conv, zga, zgb, w_oa, w_ob, w_out)
    x = x + 0.5 * mod[:, 8] * swiglu(modulate(rmsnorm(x, norm_w[2]), mod[:, 6], mod[:, 7]), ffn2_wi, ffn2_wo)
    if not last:
        oc_attn = context_attention(cq.reshape(B, L, N_HEADS, HEAD_DIM), kc, vc, sink)
        yc_conv = cb * short_conv(cc * cu, conv_w)
        xc = xc + modc[5] * gated_merge(oc_attn, yc_conv, cga, cgb, w_oa, w_ob, w_out)
        xc = xc + 0.5 * modc[8] * swiglu(modulate(rmsnorm(xc, norm_w[2]), modc[6], modc[7]), ffn2_wi, ffn2_wo)
    return x, xc


def setup_inputs(seed: int = 0) -> dict:
    key = jax.random.key(seed)
    ks = jax.random.split(key, 20)

    def nrm(k, shape, scale):
        return jax.random.normal(k, shape, jnp.float32) * scale

    return {
        'x': nrm(ks[0], (BATCH, SEQ, D_MODEL), 1.0),
        'c': nrm(ks[1], (BATCH, D_MODEL), 1.0),
        'ctx': nrm(ks[2], (BATCH, CTX_LEN, D_MODEL), 1.0),
        'c_ctx': nrm(ks[3], (D_MODEL,), 1.0),
        'w_ada': nrm(ks[4], (DEPTH, D_MODEL, N_MOD * D_MODEL), 0.5 * D_MODEL ** -0.5),
        'b_ada': nrm(ks[5], (DEPTH, N_MOD * D_MODEL), 0.02),
        'norm_w': 1.0 + nrm(ks[6], (DEPTH, 3, D_MODEL), 0.02),
        'ffn1_wi': nrm(ks[7], (DEPTH, D_MODEL, 2 * D_FF), D_MODEL ** -0.5),
        'ffn1_wo': nrm(ks[8], (DEPTH, D_FF, D_MODEL), D_FF ** -0.5),
        'w_in': nrm(ks[9], (DEPTH, D_MODEL, PROJ_W), D_MODEL ** -0.5),
        'conv_w': nrm(ks[10], (DEPTH, CONV_K, CONV_W), CONV_K ** -0.5),
        'sink': nrm(ks[11], (DEPTH, N_HEADS), 0.5),
        'w_oa': nrm(ks[12], (DEPTH, ATTN_W, D_MODEL), ATTN_W ** -0.5),
        'w_ob': nrm(ks[13], (DEPTH, CONV_W, D_MODEL), CONV_W ** -0.5),
        'w_out': nrm(ks[14], (DEPTH, D_MODEL, D_MODEL), D_MODEL ** -0.5),
        'ffn2_wi': nrm(ks[15], (DEPTH, D_MODEL, 2 * D_FF), D_MODEL ** -0.5),
        'ffn2_wo': nrm(ks[16], (DEPTH, D_FF, D_MODEL), D_FF ** -0.5),
        'final_norm_w': 1.0 + nrm(ks[17], (D_MODEL,), 0.02),
    }


def reference(x, c, ctx, c_ctx, w_ada, b_ada, norm_w, ffn1_wi, ffn1_wo, w_in, conv_w, sink,
              w_oa, w_ob, w_out, ffn2_wi, ffn2_wo, final_norm_w):
    ROWS = x.shape[1] // GRID_W
    tables = axial_rope_tables(ROWS)
    c_act = jax.nn.silu(c)
    cc_act = jax.nn.silu(c_ctx)
    xc = ctx
    for i in range(DEPTH):
        x, xc = trunk_layer(x, xc, c_act, cc_act, tables, w_ada[i], b_ada[i], norm_w[i],
                            ffn1_wi[i], ffn1_wo[i], w_in[i], conv_w[i], sink[i],
                            w_oa[i], w_ob[i], w_out[i], ffn2_wi[i], ffn2_wo[i],
                            i == DEPTH - 1)
    return rmsnorm(x, final_norm_w)
```

```cpp
#include <hip/hip_runtime.h>
#include <cstdio>
#include <cstdint>

typedef unsigned short bf16;
typedef unsigned u32x4 __attribute__((ext_vector_type(4)));

constexpr int D = 1024, BATCH = 2, SEQ = 8192, DEPTH = 2, CTX = 256, NH = 8, NKV = 2, HD = 64;
constexpr int DFF = 2816, NMOD = 9, PROJ_W = 4352;
constexpr int ML = BATCH * SEQ, MC = BATCH * CTX, R = ML + MC;
constexpr float EPS = 1e-6f;
constexpr float LOG2E = 1.4426950408889634f;
constexpr float QSCALE = 0.125f * LOG2E;
constexpr int MODS = NMOD * D;

constexpr size_t MiB = 1u << 20;
constexpr size_t WS_CTL = 0;
constexpr size_t WS_MOD = 1 * MiB;
constexpr size_t WS_ROPE = WS_MOD + 512 * 1024;
constexpr size_t WS_W = 2 * MiB;
constexpr size_t W_WI1 = 0, W_WO1 = W_WI1 + (size_t)2 * DFF * D * 2, W_WIN = W_WO1 + (size_t)D * DFF * 2, W_WM = W_WIN + (size_t)PROJ_W * D * 2,
                 W_WOUT = W_WM + (size_t)D * D * 2, W_WI2 = W_WOUT + (size_t)D * D * 2, W_WO2 = W_WI2 + (size_t)2 * DFF * D * 2, W_LAYER = W_WO2 + (size_t)D * DFF * 2;
static_assert(W_LAYER == (size_t)(45 * MiB + MiB / 2), "layer weights");
constexpr size_t WS_XC = WS_W + 2 * W_LAYER;
constexpr size_t WS_H = WS_XC + 2 * MiB;
constexpr size_t WS_U = WS_H + (size_t)R * D * 2;
constexpr size_t U_ACT = 0;
constexpr size_t U_Q = 0, U_K = U_Q + (size_t)R * 512 * 2, U_V = U_K + (size_t)R * 128 * 2, U_ZB = U_V + (size_t)R * 128 * 2, U_P = U_ZB + (size_t)R * 512 * 2,
                 U_SGA = U_P + (size_t)R * 512 * 2, U_SGB = U_SGA + (size_t)R * D * 2, U_OY = U_SGB + (size_t)R * D * 2, U_END = U_OY + (size_t)R * D * 2;
constexpr size_t U_M = U_ZB;
constexpr size_t WS_END = WS_U + U_END;
static_assert((size_t)R * DFF * 2 <= U_END, "ACT fits the union");

__device__ __forceinline__ unsigned f2bf(float f) { unsigned u = __builtin_bit_cast(unsigned, f); return (u + 0x7fffu + ((u >> 16) & 1u)) >> 16; }
__device__ __forceinline__ float bf2f(bf16 v) { return __builtin_bit_cast(float, (unsigned)v << 16); }
__device__ __forceinline__ unsigned pk2(float lo, float hi) { return f2bf(lo) | (f2bf(hi) << 16); }
__device__ __forceinline__ float wave_sum(float v) {
#pragma unroll
    for (int o = 1; o < 64; o <<= 1) v += __shfl_xor(v, o);
    return v;
}
__device__ __forceinline__ float wave_max(float v) {
#pragma unroll
    for (int o = 1; o < 64; o <<= 1) v = fmaxf(v, __shfl_xor(v, o));
    return v;
}
__device__ __forceinline__ int row_set(int r) { return r < SEQ ? 0 : (r < ML ? 1 : 2); }

__host__ __device__ __forceinline__ int src_col(int map, int np) {
    if (map == 0) return np;
    const int pn = np >> 8, w = np & 255, half = w >> 7, jj = w & 127;
    if (map == 1) return half * DFF + pn * 128 + jj;
    if (pn < 2) { const int head = pn * 4 + (jj >> 5), i = jj & 31, d1 = i < 16 ? i : i + 16; return head * 64 + d1 + (half ? 16 : 0); }
    if (pn == 2) { if (jj < 64) { const int kvh = jj >> 5, i = jj & 31, d1 = i < 16 ? i : i + 16; return 512 + kvh * 64 + d1 + (half ? 16 : 0); }
                   return 640 + half * 64 + (jj - 64); }
    if (pn < 5) return 768 + (pn - 3) * 256 + w;
    if (pn < 9) return (half ? 1792 : 1280) + (pn - 5) * 128 + jj;
    if (pn < 13) return 2304 + (pn - 9) * 256 + w;
    return 3328 + (pn - 13) * 256 + w;
}

__global__ void __launch_bounds__(256) k_rope(float* rope) {
    const int i = blockIdx.x * 256 + threadIdx.x; if (i >= 128 * 16) return;
    const int pos = i >> 4, f = i & 15;
    const float inv = exp2f(-(float)f * (13.287712379549449f / 16.0f));
    const float ang = (float)pos * inv;
    const double rev = (double)ang * 0.15915494309189535;
    const float fr = (float)(rev - floor(rev));
    rope[2 * i] = __builtin_amdgcn_cosf(fr); rope[2 * i + 1] = __builtin_amdgcn_sinf(fr);
}
__global__ void __launch_bounds__(256) k_mod(const float* c, const float* c_ctx, const float* w_ada, const float* b_ada, float* mod) {
    __shared__ float sc[3][D];
    for (int k = threadIdx.x; k < D; k += 256) {
        float v0 = c[k], v1 = c[D + k], v2 = c_ctx[k];
        sc[0][k] = v0 / (1.f + __expf(-v0)); sc[1][k] = v1 / (1.f + __expf(-v1)); sc[2][k] = v2 / (1.f + __expf(-v2));
    }
    __syncthreads();
    const int g = blockIdx.x * 256 + threadIdx.x; const int l = g / MODS, j = g % MODS;
    const float* w = w_ada + (size_t)l * D * MODS + j;
    float a0 = 0.f, a1 = 0.f, a2 = 0.f;
    for (int k = 0; k < D; ++k) { const float wv = w[(size_t)k * MODS]; a0 += sc[0][k] * wv; a1 += sc[1][k] * wv; a2 += sc[2][k] * wv; }
    const float bb = b_ada[l * MODS + j];
    mod[(l * 3 + 0) * MODS + j] = a0 + bb; mod[(l * 3 + 1) * MODS + j] = a1 + bb; mod[(l * 3 + 2) * MODS + j] = a2 + bb;
}
struct ConvJob { const float* W; bf16* dst; int K, N, Nd, ldk, koff, map; };
__global__ void __launch_bounds__(256) k_convert(ConvJob job) {
    __shared__ float scr_all[4][64 * 33];
    const int lane = threadIdx.x & 63, wave = threadIdx.x >> 6; float* scr = scr_all[wave];
    const int nblk = job.Nd / 32, items = (job.K / 64) * nblk;
    for (int it = blockIdx.x * 4 + wave; it < items; it += gridDim.x * 4) {
        const int kb = it / nblk, nb = it % nblk, k0 = 64 * kb, n0 = 32 * nb;
        const int sc = src_col(job.map, n0 + (lane & 31));
#pragma unroll 8
        for (int i = 0; i < 32; ++i) { const int kk = 2 * i + (lane >> 5); scr[kk * 33 + (lane & 31)] = job.W[(size_t)(k0 + kk) * job.N + sc]; }
        __builtin_amdgcn_wave_barrier(); asm volatile("s_waitcnt lgkmcnt(0)" ::: "memory");
        const int c = lane & 7;
#pragma unroll
        for (int j = 0; j < 4; ++j) { const int n = (lane >> 3) + 8 * j; const float* s = scr + (8 * c) * 33 + n;
            u32x4 o; o.x = pk2(s[0 * 33], s[1 * 33]); o.y = pk2(s[2 * 33], s[3 * 33]); o.z = pk2(s[4 * 33], s[5 * 33]); o.w = pk2(s[6 * 33], s[7 * 33]);
            *(u32x4*)(job.dst + (size_t)(n0 + n) * job.ldk + job.koff + k0 + 8 * c) = o; }
        __builtin_amdgcn_wave_barrier(); asm volatile("s_waitcnt lgkmcnt(0)" ::: "memory");
    }
}
__global__ void __launch_bounds__(256) k_norm_mod(const float* XL, const float* XCp, const float* nw, const float* modl, int ishift, int iscale, bf16* H) {
    const int lane = threadIdx.x & 63, r = blockIdx.x * 4 + (threadIdx.x >> 6); if (r >= R) return;
    const float* x = r < ML ? XL + (size_t)r * D : XCp + (size_t)(r - ML) * D; const int set = row_set(r);
    const float* sh = modl + set * MODS + ishift * D; const float* scl = modl + set * MODS + iscale * D;
    float v[16]; float ss = 0.f;
#pragma unroll
    for (int j = 0; j < 4; ++j) { const float4 q = *(const float4*)(x + 256 * j + 4 * lane); v[4 * j] = q.x; v[4 * j + 1] = q.y; v[4 * j + 2] = q.z; v[4 * j + 3] = q.w; ss += q.x * q.x + q.y * q.y + q.z * q.z + q.w * q.w; }
    const float rstd = rsqrtf(wave_sum(ss) * (1.f / D) + EPS);
#pragma unroll
    for (int j = 0; j < 4; ++j) { const int k = 256 * j + 4 * lane; float o[4];
#pragma unroll
        for (int e = 0; e < 4; ++e) o[e] = (v[4 * j + e] * rstd * nw[k + e]) * (1.f + scl[k + e]) + sh[k + e];
        uint2 w; w.x = pk2(o[0], o[1]); w.y = pk2(o[2], o[3]); *(uint2*)(H + (size_t)r * D + k) = w; }
}
__global__ void __launch_bounds__(256) k_final_norm(float* X, const float* fw) {
    const int lane = threadIdx.x & 63, r = blockIdx.x * 4 + (threadIdx.x >> 6); if (r >= ML) return;
    float* x = X + (size_t)r * D; float4 q[4]; float ss = 0.f;
#pragma unroll
    for (int j = 0; j < 4; ++j) { q[j] = *(const float4*)(x + 256 * j + 4 * lane); ss += q[j].x * q[j].x + q[j].y * q[j].y + q[j].z * q[j].z + q[j].w * q[j].w; }
    const float rstd = rsqrtf(wave_sum(ss) * (1.f / D) + EPS);
#pragma unroll
    for (int j = 0; j < 4; ++j) { const float4 w = *(const float4*)(fw + 256 * j + 4 * lane); float4 o; o.x = q[j].x * rstd * w.x; o.y = q[j].y * rstd * w.y; o.z = q[j].z * rstd * w.z; o.w = q[j].w * rstd * w.w; *(float4*)(x + 256 * j + 4 * lane) = o; }
}

template <class Epi, bool SPLIT>
__global__ void __launch_bounds__(256) k_gemm_naive(const bf16* A, const bf16* Bt, int K, int Ksplit, Epi E) {
    __shared__ float As[32][65], Bs[32][65];
    const int tid = threadIdx.x, tx = tid & 15, ty = tid >> 4; const int ct = blockIdx.x, pn = ct >> 2, st = ct & 3, r0 = blockIdx.y * 64;
    float acc[2][4][4];
#pragma unroll
    for (int s = 0; s < 2; ++s)
#pragma unroll
        for (int i = 0; i < 4; ++i)
#pragma unroll
            for (int j = 0; j < 4; ++j) acc[s][i][j] = 0.f;
    const int lr = tid >> 2, lk = (tid & 3) * 8;
    const int brow = pn * 256 + (lr < 32 ? st * 32 + lr : 128 + st * 32 + (lr - 32));
    const bf16* ap = A + (size_t)(r0 + lr) * K + lk; const bf16* bp = Bt + (size_t)brow * K + lk;
    for (int k0 = 0; k0 < K; k0 += 32) {
        const u32x4 av = *(const u32x4*)(ap + k0), bv = *(const u32x4*)(bp + k0);
        __syncthreads();
#pragma unroll
        for (int e = 0; e < 4; ++e) { As[lk + 2 * e][lr] = __builtin_bit_cast(float, av[e] << 16); As[lk + 2 * e + 1][lr] = __builtin_bit_cast(float, av[e] & 0xffff0000u);
                                      Bs[lk + 2 * e][lr] = __builtin_bit_cast(float, bv[e] << 16); Bs[lk + 2 * e + 1][lr] = __builtin_bit_cast(float, bv[e] & 0xffff0000u); }
        __syncthreads();
        const int s = (SPLIT && k0 >= Ksplit) ? 1 : 0;
#pragma unroll 8
        for (int kk = 0; kk < 32; ++kk) { float a[4], b[4];
#pragma unroll
            for (int i = 0; i < 4; ++i) { a[i] = As[kk][ty * 4 + i]; b[i] = Bs[kk][tx + 16 * i]; }
            if (SPLIT && s) {
#pragma unroll
                for (int i = 0; i < 4; ++i)
#pragma unroll
                    for (int j = 0; j < 4; ++j) acc[1][i][j] += a[i] * b[j];
            } else {
#pragma unroll
                for (int i = 0; i < 4; ++i)
#pragma unroll
                    for (int j = 0; j < 4; ++j) acc[0][i][j] += a[i] * b[j];
            } }
    }
#pragma unroll
    for (int i = 0; i < 4; ++i) { const int r = r0 + ty * 4 + i;
        E.pair(r, pn, st * 32 + tx, acc[0][i][0], acc[0][i][2], acc[1][i][0], acc[1][i][2]);
        E.pair(r, pn, st * 32 + tx + 16, acc[0][i][1], acc[0][i][3], acc[1][i][1], acc[1][i][3]); }
}
struct EpiSwiglu { bf16* ACT;
    __device__ __forceinline__ void pair(int r, int pn, int jj, float a, float g, float, float) const { ACT[(size_t)r * DFF + pn * 128 + jj] = (bf16)f2bf(a * g / (1.f + __expf(-g))); } };
struct EpiResid { float* XL; float* XCp; const float* gate; float gs; int pad;
    __device__ __forceinline__ void pair(int r, int pn, int jj, float h0, float h1, float, float) const {
        float* x = r < ML ? XL + (size_t)r * D : XCp + (size_t)(r - ML) * D; const float* g = gate + row_set(r) * MODS; const int c0 = pn * 256 + jj, c1 = c0 + 128;
        x[c0] += gs * g[c0] * h0; x[c1] += gs * g[c1] * h1; } };
struct EpiWin { bf16 *Q, *K, *V, *ZB, *P, *SGA, *SGB; const float* rope;
    __device__ __forceinline__ void pair(int r, int pn, int jj, float h0, float h1, float, float) const {
        if (pn <= 2 && (pn < 2 || jj < 64)) {
            const int i = jj & 31, d1 = i < 16 ? i : i + 16, f = i & 15; float y1 = h0, y2 = h1;
            if (r < ML) { const int t = r % SEQ, pos = i < 16 ? (t >> 6) : (t & 63); const float c = rope[(pos * 16 + f) * 2], s = rope[(pos * 16 + f) * 2 + 1]; y1 = h0 * c - h1 * s; y2 = h1 * c + h0 * s; }
            if (pn < 2) { const int head = pn * 4 + (jj >> 5); bf16* q = Q + (size_t)r * 512 + head * 64 + d1; q[0] = (bf16)f2bf(y1 * QSCALE); q[16] = (bf16)f2bf(y2 * QSCALE); }
            else { const int kvh = jj >> 5; bf16* k = K + (size_t)r * 128 + kvh * 64 + d1; k[0] = (bf16)f2bf(y1); k[16] = (bf16)f2bf(y2); }
        } else if (pn == 2) { bf16* v = V + (size_t)r * 128 + (jj - 64); v[0] = (bf16)f2bf(h0); v[64] = (bf16)f2bf(h1); }
        else if (pn < 5) { bf16* z = ZB + (size_t)r * 512 + (pn - 3) * 256 + jj; z[0] = (bf16)f2bf(h0); z[128] = (bf16)f2bf(h1); }
        else if (pn < 9) { P[(size_t)r * 512 + (pn - 5) * 128 + jj] = (bf16)f2bf(h0 * h1); }
        else { bf16* g = (pn < 13 ? SGA + (size_t)r * D + (pn - 9) * 256 : SGB + (size_t)r * D + (pn - 13) * 256) + jj; g[0] = (bf16)f2bf(1.f / (1.f + __expf(-h0))); g[128] = (bf16)f2bf(1.f / (1.f + __expf(-h1))); }
    } };
struct EpiMerge { const bf16 *SGA, *SGB; bf16* M;
    __device__ __forceinline__ void pair(int r, int pn, int jj, float a0, float a1, float b0, float b1) const {
        const size_t o = (size_t)r * D + pn * 256 + jj;
        M[o] = (bf16)f2bf(bf2f(SGA[o]) * a0 + bf2f(SGB[o]) * b0); M[o + 128] = (bf16)f2bf(bf2f(SGA[o + 128]) * a1 + bf2f(SGB[o + 128]) * b1); } };

__global__ void __launch_bounds__(256) k_attn_naive(const bf16* Q, const bf16* K, const bf16* V, const float* sink, bf16* OY) {
    __shared__ float qs[4][64]; __shared__ float ps[4][640];
    const int r = blockIdx.x, kh = blockIdx.y, wave = threadIdx.x >> 6, lane = threadIdx.x & 63, h = kh * 4 + wave;
    qs[wave][lane] = bf2f(Q[(size_t)r * 512 + h * 64 + lane]);
    const bool lat = r < ML; const int b = lat ? r / SEQ : (r - ML) / CTX, t = lat ? r % SEQ : 0, n = t >> 7;
    const int nslots = lat ? 640 : 256;
    __syncthreads();
    float sc[10]; float mx = -3.0e38f;
#pragma unroll
    for (int i = 0; i < 10; ++i) { const int s = lane + 64 * i; bool valid = false; int krow = 0;
        if (s < 256) { krow = ML + b * CTX + s; valid = true; }
        else if (lat) { const int kpos = (n - 1) * 128 + (s - 256); const int dlt = kpos - t; valid = kpos >= 0 && kpos < SEQ && dlt <= 128 && dlt >= -128; krow = b * SEQ + kpos; }
        float dot = -3.0e38f;
        if (valid) { dot = 0.f; const bf16* kp = K + (size_t)krow * 128 + kh * 64;
#pragma unroll 8
            for (int d = 0; d < 64; ++d) dot += qs[wave][d] * bf2f(kp[d]); }
        sc[i] = dot; mx = fmaxf(mx, dot); }
    const float sk = sink[h] * LOG2E;
    mx = fmaxf(wave_max(mx), sk);
    float lsum = 0.f;
#pragma unroll
    for (int i = 0; i < 10; ++i) { const int s = lane + 64 * i; const float p = sc[i] > -1.0e38f ? exp2f(sc[i] - mx) : 0.f; ps[wave][s] = p; lsum += p; }
    lsum = wave_sum(lsum) + exp2f(sk - mx);
    __syncthreads();
    float o = 0.f;
    for (int s = 0; s < nslots; ++s) { const float p = ps[wave][s]; if (p != 0.f) { const int krow = s < 256 ? ML + b * CTX + s : b * SEQ + (n - 1) * 128 + (s - 256); o += p * bf2f(V[(size_t)krow * 128 + kh * 64 + lane]); } }
    OY[(size_t)r * D + h * 64 + lane] = (bf16)f2bf(o / lsum);
}
__global__ void __launch_bounds__(256) k_conv(const bf16* ZB, const bf16* P, const float* cw, bf16* OY) {
    const int g = blockIdx.x * 256 + threadIdx.x; const int r = g >> 9, j = g & 511; if (r >= R) return;
    bool first, last; if (r < ML) { const int t = r % SEQ; first = t == 0; last = t == SEQ - 1; } else { const int l = (r - ML) % CTX; first = l == 0; last = l == CTX - 1; }
    const float pm = first ? 0.f : bf2f(P[(size_t)(r - 1) * 512 + j]), p0 = bf2f(P[(size_t)r * 512 + j]), pp = last ? 0.f : bf2f(P[(size_t)(r + 1) * 512 + j]);
    const float y = bf2f(ZB[(size_t)r * 512 + j]) * (cw[j] * pm + cw[512 + j] * p0 + cw[1024 + j] * pp);
    OY[(size_t)r * D + 512 + j] = (bf16)f2bf(y);
}

extern "C" void kernel_launch(void* const* d_in, const int* in_sizes, int n_in, void* d_out, int out_size, void* d_ws, size_t ws_size, hipStream_t stream) {
    if (n_in != 18 || in_sizes[0] != ML * D || out_size != ML * D || ws_size < WS_END) { fprintf(stderr, "kernel_launch: unexpected shapes (n_in %d, in0 %d, out %d, ws %zu < %zu)\n", n_in, n_in > 0 ? in_sizes[0] : -1, out_size, ws_size, (size_t)WS_END); return; }
    const float* x = (const float*)d_in[0]; const float* c = (const float*)d_in[1]; const float* ctx = (const float*)d_in[2]; const float* c_ctx = (const float*)d_in[3];
    const float* w_ada = (const float*)d_in[4]; const float* b_ada = (const float*)d_in[5]; const float* norm_w = (const float*)d_in[6];
    const float* ffn1_wi = (const float*)d_in[7]; const float* ffn1_wo = (const float*)d_in[8]; const float* w_in = (const float*)d_in[9]; const float* conv_w = (const float*)d_in[10];
    const float* sink = (const float*)d_in[11]; const float* w_oa = (const float*)d_in[12]; const float* w_ob = (const float*)d_in[13]; const float* w_out = (const float*)d_in[14];
    const float* ffn2_wi = (const float*)d_in[15]; const float* ffn2_wo = (const float*)d_in[16]; const float* final_w = (const float*)d_in[17];
    unsigned char* ws = (unsigned char*)d_ws; float* XL = (float*)d_out; float* XCp = (float*)(ws + WS_XC); float* mod = (float*)(ws + WS_MOD); float* rope = (float*)(ws + WS_ROPE);
    bf16* H = (bf16*)(ws + WS_H); unsigned char* U = ws + WS_U;
    bf16 *ACT = (bf16*)(U + U_ACT), *Qb = (bf16*)(U + U_Q), *Kb = (bf16*)(U + U_K), *Vb = (bf16*)(U + U_V), *ZB = (bf16*)(U + U_ZB), *Pb = (bf16*)(U + U_P), *SGA = (bf16*)(U + U_SGA), *SGB = (bf16*)(U + U_SGB),
         *OY = (bf16*)(U + U_OY), *Mb = (bf16*)(U + U_M);
    (void)hipMemcpyAsync(XL, x, (size_t)ML * D * 4, hipMemcpyDeviceToDevice, stream);
    (void)hipMemcpyAsync(XCp, ctx, (size_t)MC * D * 4, hipMemcpyDeviceToDevice, stream);
    k_rope<<<8, 256, 0, stream>>>(rope);
    k_mod<<<DEPTH * MODS / 256, 256, 0, stream>>>(c, c_ctx, w_ada, b_ada, mod);
    for (int l = 0; l < DEPTH; ++l) {
        unsigned char* wl = ws + WS_W + l * W_LAYER;
        ConvJob jobs[8] = {
            {ffn1_wi + (size_t)l * D * 2 * DFF, (bf16*)(wl + W_WI1), D, 2 * DFF, 2 * DFF, D, 0, 1},
            {ffn1_wo + (size_t)l * DFF * D, (bf16*)(wl + W_WO1), DFF, D, D, DFF, 0, 0},
            {w_in + (size_t)l * D * PROJ_W, (bf16*)(wl + W_WIN), D, PROJ_W, PROJ_W, D, 0, 2},
            {w_oa + (size_t)l * 512 * D, (bf16*)(wl + W_WM), 512, D, D, D, 0, 0},
            {w_ob + (size_t)l * 512 * D, (bf16*)(wl + W_WM), 512, D, D, D, 512, 0},
            {w_out + (size_t)l * D * D, (bf16*)(wl + W_WOUT), D, D, D, D, 0, 0},
            {ffn2_wi + (size_t)l * D * 2 * DFF, (bf16*)(wl + W_WI2), D, 2 * DFF, 2 * DFF, D, 0, 1},
            {ffn2_wo + (size_t)l * DFF * D, (bf16*)(wl + W_WO2), DFF, D, D, DFF, 0, 0} };
        for (int j = 0; j < 8; ++j) k_convert<<<1024, 256, 0, stream>>>(jobs[j]);
    }
    for (int l = 0; l < DEPTH; ++l) {
        unsigned char* wl = ws + WS_W + l * W_LAYER; const float* modl = mod + l * 3 * MODS; const float* nw = norm_w + l * 3 * D;
        k_norm_mod<<<R / 4, 256, 0, stream>>>(XL, XCp, nw, modl, 0, 1, H);
        k_gemm_naive<EpiSwiglu, false><<<dim3(2 * DFF / 64, R / 64), 256, 0, stream>>>(H, (const bf16*)(wl + W_WI1), D, 0, EpiSwiglu{ACT});
        k_gemm_naive<EpiResid, false><<<dim3(D / 64, R / 64), 256, 0, stream>>>(ACT, (const bf16*)(wl + W_WO1), DFF, 0, EpiResid{XL, XCp, modl + 2 * D, 0.5f, 0});
        k_norm_mod<<<R / 4, 256, 0, stream>>>(XL, XCp, nw + D, modl, 3, 4, H);
        k_gemm_naive<EpiWin, false><<<dim3(PROJ_W / 64, R / 64), 256, 0, stream>>>(H, (const bf16*)(wl + W_WIN), D, 0, EpiWin{Qb, Kb, Vb, ZB, Pb, SGA, SGB, rope});
        k_attn_naive<<<dim3(R, NKV), 256, 0, stream>>>(Qb, Kb, Vb, sink + l * NH, OY);
        k_conv<<<R * 512 / 256, 256, 0, stream>>>(ZB, Pb, conv_w + l * 3 * 512, OY);
        k_gemm_naive<EpiMerge, true><<<dim3(D / 64, R / 64), 256, 0, stream>>>(OY, (const bf16*)(wl + W_WM), D, 512, EpiMerge{SGA, SGB, Mb});
        k_gemm_naive<EpiResid, false><<<dim3(D / 64, R / 64), 256, 0, stream>>>(Mb, (const bf16*)(wl + W_WOUT), D, 0, EpiResid{XL, XCp, modl + 5 * D, 1.0f, 0});
        k_norm_mod<<<R / 4, 256, 0, stream>>>(XL, XCp, nw + 2 * D, modl, 6, 7, H);
        k_gemm_naive<EpiSwiglu, false><<<dim3(2 * DFF / 64, R / 64), 256, 0, stream>>>(H, (const bf16*)(wl + W_WI2), D, 0, EpiSwiglu{ACT});
        k_gemm_naive<EpiResid, false><<<dim3(D / 64, R / 64), 256, 0, stream>>>(ACT, (const bf16*)(wl + W_WO2), DFF, 0, EpiResid{XL, XCp, modl + 8 * D, 0.5f, 0});
    }
    k_final_norm<<<ML / 4, 256, 0, stream>>>(XL, final_w);
}
```

```cpp
#include <hip/hip_runtime.h>
#include <cstdio>
#include <cstdint>

#define LAS __attribute__((address_space(3)))
typedef unsigned short bf16;
typedef float f32x2 __attribute__((ext_vector_type(2)));
typedef unsigned u32x2 __attribute__((ext_vector_type(2)));

constexpr int D = 1024, BATCH = 2, SEQ = 8192, DEPTH = 2, CTX = 256, NH = 8, NKV = 2, HD = 64;
constexpr int DFF = 2816, NMOD = 9, PROJ_W = 4352;
constexpr int ML = BATCH * SEQ, MC = BATCH * CTX, R = ML + MC;
constexpr float EPS = 1e-6f;
constexpr float LOG2E = 1.4426950408889634f;
constexpr float QSCALE = 0.125f * LOG2E;
constexpr int MODS = NMOD * D;
constexpr int SWN = 2 * DFF;

constexpr size_t MiB = 1u << 20;
constexpr size_t WS_CTL = 0;
constexpr size_t WS_MOD = 1 * MiB;
constexpr size_t ZERO_BYTES = WS_MOD + 256 * 1024;
constexpr size_t WS_ROPE = WS_MOD + 256 * 1024;
constexpr size_t WS_SW = WS_MOD + 512 * 1024;
constexpr size_t WS_W = 2 * MiB;
constexpr size_t W_WI1 = 0, W_WO1 = W_WI1 + (size_t)2 * DFF * D * 2, W_WIN = W_WO1 + (size_t)D * DFF * 2, W_WM = W_WIN + (size_t)PROJ_W * D * 2,
                 W_WOUT = W_WM + (size_t)D * D * 2, W_WI2 = W_WOUT + (size_t)D * D * 2, W_WO2 = W_WI2 + (size_t)2 * DFF * D * 2, W_LAYER = W_WO2 + (size_t)D * DFF * 2;
static_assert(W_LAYER == (size_t)(45 * MiB + MiB / 2), "layer weights");
static_assert(WS_SW + (size_t)2 * 3 * 3 * SWN * 4 <= WS_W, "sW fits");
constexpr size_t WS_XC = WS_W + 2 * W_LAYER;
constexpr size_t WS_SSQ = WS_XC + 2 * MiB;
constexpr size_t WS_XT = WS_SSQ + 2 * MiB;
constexpr size_t WS_U = WS_XT + (size_t)R * D * 2;
constexpr size_t U_ACT = 0;
constexpr size_t U_Q = 0, U_K = U_Q + (size_t)R * 512 * 2, U_V = U_K + (size_t)R * 128 * 2, U_ZB = U_V + (size_t)R * 128 * 2, U_P = U_ZB + (size_t)R * 512 * 2,
                 U_SGA = U_P + (size_t)R * 512 * 2, U_SGB = U_SGA + (size_t)R * D * 2, U_OY = U_SGB + (size_t)R * D * 2, U_END = U_OY + (size_t)R * D * 2;
constexpr size_t U_M = U_ZB;
constexpr size_t WS_END = WS_U + U_END;
static_assert((size_t)R * DFF * 2 <= U_END && (size_t)R * 16 * 4 <= 2 * MiB, "ACT fits the union; SSQ fits");

constexpr int RING_BYTES = 131072;
constexpr int MISC_OFF = RING_BYTES + 320;
constexpr int LDS_BYTES = 147456;
constexpr int NWAVES = 8;

__device__ __forceinline__ unsigned f2bf(float f) { unsigned u = __builtin_bit_cast(unsigned, f); return (u + 0x7fffu + ((u >> 16) & 1u)) >> 16; }
__device__ __forceinline__ float bf2f(bf16 v) { return __builtin_bit_cast(float, (unsigned)v << 16); }
__device__ __forceinline__ float bflo(unsigned w) { return __builtin_bit_cast(float, w << 16); }
__device__ __forceinline__ float bfhi(unsigned w) { return __builtin_bit_cast(float, w & 0xffff0000u); }
__device__ __forceinline__ unsigned pk2(float lo, float hi) { return f2bf(lo) | (f2bf(hi) << 16); }
__device__ __forceinline__ float wave_sum(float v) {
#pragma unroll
    for (int o = 1; o < 64; o <<= 1) v += __shfl_xor(v, o);
    return v;
}
__device__ __forceinline__ float wave_max(float v) {
#pragma unroll
    for (int o = 1; o < 64; o <<= 1) v = fmaxf(v, __shfl_xor(v, o));
    return v;
}
__device__ __forceinline__ float fast_rcp(float x) { return __builtin_amdgcn_rcpf(x); }
__device__ __forceinline__ float fast_exp2(float x) { return __builtin_amdgcn_exp2f(x); }
__device__ __forceinline__ float sigmoid_f(float x) { return fast_rcp(1.f + fast_exp2(-x * LOG2E)); }

__host__ __device__ __forceinline__ int src_col(int map, int np) {
    if (map == 0) return np;
    const int pn = np >> 8, w = np & 255, half = w >> 7, jj = w & 127;
    if (map == 1) return half * DFF + pn * 128 + jj;
    if (pn < 2) { const int head = pn * 4 + (jj >> 5), i = jj & 31, d1 = i < 16 ? i : i + 16; return head * 64 + d1 + (half ? 16 : 0); }
    if (pn == 2) { if (jj < 64) { const int kvh = jj >> 5, i = jj & 31, d1 = i < 16 ? i : i + 16; return 512 + kvh * 64 + d1 + (half ? 16 : 0); }
                   return 640 + half * 64 + (jj - 64); }
    if (pn < 5) return 768 + (pn - 3) * 256 + w;
    if (pn < 9) return (half ? 1792 : 1280) + (pn - 5) * 128 + jj;
    if (pn < 13) return 2304 + (pn - 9) * 256 + w;
    return 3328 + (pn - 13) * 256 + w;
}


namespace pg8 {
#define PG8_LAS __attribute__((address_space(3)))
typedef unsigned short bf16_t;
typedef short bf16x8 __attribute__((ext_vector_type(8)));
typedef float f32x4 __attribute__((ext_vector_type(4)));
typedef unsigned u32x4 __attribute__((ext_vector_type(4)));

constexpr int BM = 256, BK = 64, HALF = 128, HTB = HALF * BK * 2  , STAGE_BYTES = 8 * HTB, NXCD = 8, WGM = 8;

__host__ __device__ __forceinline__ int lds_byte(int r, int c) { const int st = (r >> 4) * 2 + (c >> 5), rr = r & 15, cc = c & 31, ob = rr * 64 + cc * 2; return st * 1024 + (ob ^ (((ob >> 9) & 1) << 5)); }
__host__ __device__ __forceinline__ void stage_rc(int b, int& R, int& C) { const int st = b / 1024, sb = b % 1024, swz = sb ^ (((sb >> 9) & 1) << 5); R = (st >> 1) * 16 + swz / 64; C = (st & 1) * 32 + (swz % 64) / 2; }
__host__ __device__ __forceinline__ int perm32(int rho) { const int n = rho >> 4, i = rho & 15; return 8 * (i >> 2) + 4 * n + (i & 3); }

struct Unit { int pm, pn; };
struct Gemm { const bf16_t* A; const bf16_t* Bt; int M, N, K; };

struct StaticOrder {
    int nM, nN, nwg, G, c;
    __host__ __device__ void init(int M, int N, int G_, int c_) { nM = M / BM; nN = N / BM; nwg = nM * nN; G = G_; c = c_; }
    __host__ __device__ bool next(int i, Unit& u) const {
        const long L = (long)i * G + c; if (L >= nwg) return false;
        int wgid = (int)L; { const int q = nwg / NXCD, r = nwg % NXCD, xcd = wgid % NXCD, off = wgid / NXCD; wgid = (xcd < r ? xcd * (q + 1) : r * (q + 1) + (xcd - r) * q) + off; }
        const int nig = WGM * nN, gid = wgid / nig, fm = gid * WGM, gsz = (nM - fm) < WGM ? (nM - fm) : WGM;
        u.pm = fm + ((wgid % nig) % gsz); u.pn = (wgid % nig) / gsz; return true;
    }
    __device__ __forceinline__ void a_ready(const Unit&) const {}
    __device__ __forceinline__ void done(const Unit&) const {}
};

__device__ __forceinline__ unsigned cvt_pk_bf16(float lo, float hi) { unsigned r; asm volatile("v_cvt_pk_bf16_f32 %0, %1, %2" : "=v"(r) : "v"(lo), "v"(hi)); return r; }


__device__ __forceinline__ int tile_set(int pm) { return pm < 32 ? 0 : (pm < 64 ? 1 : 2); }
__device__ __forceinline__ float rstd_row(const float* ssq, int r) {
    const f32x4* p = (const f32x4*)(ssq + (size_t)r * 16); const f32x4 a = p[0], b = p[1], c = p[2], d = p[3];
    const float s = (((a[0] + a[1]) + (a[2] + a[3])) + ((b[0] + b[1]) + (b[2] + b[3]))) + (((c[0] + c[1]) + (c[2] + c[3])) + ((d[0] + d[1]) + (d[2] + d[3])));
    return rsqrtf(s * (1.0f / D) + EPS);
}
__device__ __forceinline__ u32x4 pack8(const f32x4& v0, const f32x4& v1) { u32x4 w; w.x = cvt_pk_bf16(v0[0], v0[1]); w.y = cvt_pk_bf16(v0[2], v0[3]); w.z = cvt_pk_bf16(v1[0], v1[1]); w.w = cvt_pk_bf16(v1[2], v1[3]); return w; }

struct EpiSwigluF {
    static constexpr bool PERM = true, AFTER_DRAIN = false; static constexpr int MID_T = 0;
    bf16_t* ACT; const float* ssq; const float* sw;
    __device__ __forceinline__ void mid(f32x4 (&)[2][2][4][2], const Unit&, int, int, int, int) const {}
    __device__ __forceinline__ void operator()(const f32x4 (&acc)[2][2][4][2], const Unit& u, int wr, int wc, int fr, int fq) const {
        const int set = tile_set(u.pm), row0 = u.pm * BM + wr * 64 + fr, jj0 = wc * 32 + 8 * fq;
        const float* swp = sw + set * SWN + u.pn * BM + jj0;
        f32x4 sa[2], sg[2];
#pragma unroll
        for (int n = 0; n < 2; ++n) { sa[n] = *(const f32x4*)(swp + 4 * n); sg[n] = *(const f32x4*)(swp + HALF + 4 * n); }
#pragma unroll
        for (int ai = 0; ai < 2; ++ai)
#pragma unroll
            for (int m = 0; m < 4; ++m) { const int r = row0 + ai * HALF + m * 16; const float rs = rstd_row(ssq, r); f32x4 o[2];
#pragma unroll
                for (int n = 0; n < 2; ++n) { const f32x4 av = acc[ai][0][m][n] * rs + sa[n], gv = acc[ai][1][m][n] * rs + sg[n];
#pragma unroll
                    for (int e = 0; e < 4; ++e) o[n][e] = av[e] * gv[e] * fast_rcp(1.f + fast_exp2(-gv[e] * LOG2E)); }
                *(u32x4*)(ACT + (size_t)r * DFF + u.pn * HALF + jj0) = pack8(o[0], o[1]);
                if (m & 1) asm volatile("" ::: "memory"); }
    }
};
template <int GS2> struct EpiResidF {
    static constexpr bool PERM = false, AFTER_DRAIN = false; static constexpr int MID_T = 0;
    float* XL; float* XCp; const float* gate; const float* nwn; const float* scn; bf16_t* XT; float* ssq;
    __device__ __forceinline__ void mid(f32x4 (&)[2][2][4][2], const Unit&, int, int, int, int) const {}
    __device__ __forceinline__ void operator()(const f32x4 (&acc)[2][2][4][2], const Unit& u, int wr, int wc, int fr, int fq) const {
        const int set = tile_set(u.pm), col0 = u.pn * BM + wc * 32 + 4 * fq;
        char* xb = (char*)(u.pm < 64 ? XL + (size_t)u.pm * BM * D : XCp + (size_t)(u.pm - 64) * BM * D);
        char* tb = (char*)(XT + (size_t)u.pm * BM * D);
        const unsigned off0 = (unsigned)((wr * 64 + fr) * D + col0);
        const float* gp = gate + set * MODS + col0; const float* sp = scn + set * MODS + col0; const float* np = nwn + col0;
        f32x4 ss0 = {0.f, 0.f, 0.f, 0.f}, ss1 = {0.f, 0.f, 0.f, 0.f};
#pragma unroll
        for (int bj = 0; bj < 2; ++bj)
#pragma unroll
            for (int n = 0; n < 2; ++n) { const int cc = bj * HALF + n * 16; const f32x4 g = *(const f32x4*)(gp + cc) * (0.5f * GS2);
                const f32x4 cw = *(const f32x4*)(np + cc) * (*(const f32x4*)(sp + cc) + 1.0f);
#pragma unroll
                for (int ai = 0; ai < 2; ++ai)
#pragma unroll
                    for (int m = 0; m < 4; ++m) { const unsigned off = off0 + (unsigned)((ai * HALF + m * 16) * D + cc);
                        f32x4* xp = (f32x4*)(xb + (size_t)off * 4u); const f32x4 xv = *xp + g * acc[ai][bj][m][n]; *xp = xv;
                        { const float q = (xv[0] * xv[0] + xv[1] * xv[1]) + (xv[2] * xv[2] + xv[3] * xv[3]); if (ai == 0) ss0[m] += q; else ss1[m] += q; }
                        { const f32x4 t = xv * cw; u32x2 w; w.x = cvt_pk_bf16(t[0], t[1]); w.y = cvt_pk_bf16(t[2], t[3]); *(u32x2*)(tb + (size_t)off * 2u) = w; } }
                asm volatile("" ::: "memory"); }
        float* sq = ssq + (size_t)(u.pm * BM + wr * 64 + fr) * 16 + u.pn * 4 + wc;
#pragma unroll
        for (int ai = 0; ai < 2; ++ai)
#pragma unroll
            for (int m = 0; m < 4; ++m) { float v = ai == 0 ? ss0[m] : ss1[m]; v += __shfl_xor(v, 16); v += __shfl_xor(v, 32); if (fq == 0) sq[(ai * HALF + m * 16) * 16] = v; }
    }
};
struct EpiWinF {
    static constexpr bool PERM = true, AFTER_DRAIN = false; static constexpr int MID_T = 0;
    bf16_t *Q, *K, *V, *ZB, *P, *SGA, *SGB; const float* rope; const float* ssq; const float* sw;
    __device__ __forceinline__ void mid(f32x4 (&)[2][2][4][2], const Unit&, int, int, int, int) const {}
    __device__ __forceinline__ void operator()(const f32x4 (&acc)[2][2][4][2], const Unit& u, int wr, int wc, int fr, int fq) const {
        const int set = tile_set(u.pm), row0 = u.pm * BM + wr * 64 + fr, jj0 = wc * 32 + 8 * fq, pn = u.pn;
        const float* swp = sw + set * SWN + pn * BM + jj0;
        f32x4 s0[2], s1[2];
#pragma unroll
        for (int n = 0; n < 2; ++n) { s0[n] = *(const f32x4*)(swp + 4 * n); s1[n] = *(const f32x4*)(swp + HALF + 4 * n); }
        const bool is_rope = pn < 2 || (pn == 2 && wc < 2);
#pragma unroll
        for (int ai = 0; ai < 2; ++ai)
#pragma unroll
            for (int m = 0; m < 4; ++m) { const int r = row0 + ai * HALF + m * 16; const float rs = rstd_row(ssq, r);
                f32x4 h0[2], h1[2];
#pragma unroll
                for (int n = 0; n < 2; ++n) { h0[n] = acc[ai][0][m][n] * rs + s0[n]; h1[n] = acc[ai][1][m][n] * rs + s1[n]; }
                if (is_rope) {
                    if (u.pm < 64) { const int t = r & (SEQ - 1), pos = fq < 2 ? (t >> 6) : (t & 63);
                        const f32x4* rp = (const f32x4*)(rope + (pos * 16 + 8 * (fq & 1)) * 2);
#pragma unroll
                        for (int n = 0; n < 2; ++n) { const f32x4 cs0 = rp[2 * n], cs1 = rp[2 * n + 1];
                            const f32x4 cc = (f32x4){cs0[0], cs0[2], cs1[0], cs1[2]}, sn = (f32x4){cs0[1], cs0[3], cs1[1], cs1[3]};
                            const f32x4 y1 = h0[n] * cc - h1[n] * sn, y2 = h1[n] * cc + h0[n] * sn; h0[n] = y1; h1[n] = y2; } }
                    const int d10 = fq < 2 ? 8 * fq : 16 + 8 * fq;
                    if (pn < 2) { bf16_t* dst = Q + (size_t)r * 512 + (pn * 4 + wc) * 64 + d10;
                        *(u32x4*)dst = pack8(h0[0] * QSCALE, h0[1] * QSCALE); *(u32x4*)(dst + 16) = pack8(h1[0] * QSCALE, h1[1] * QSCALE); }
                    else { bf16_t* dst = K + (size_t)r * 128 + wc * 64 + d10; *(u32x4*)dst = pack8(h0[0], h0[1]); *(u32x4*)(dst + 16) = pack8(h1[0], h1[1]); }
                } else if (pn == 2) { bf16_t* dst = V + (size_t)r * 128 + (wc - 2) * 32 + 8 * fq; *(u32x4*)dst = pack8(h0[0], h0[1]); *(u32x4*)(dst + 64) = pack8(h1[0], h1[1]); }
                else if (pn < 5) { bf16_t* dst = ZB + (size_t)r * 512 + (pn - 3) * BM + jj0; *(u32x4*)dst = pack8(h0[0], h0[1]); *(u32x4*)(dst + HALF) = pack8(h1[0], h1[1]); }
                else if (pn < 9) { bf16_t* dst = P + (size_t)r * 512 + (pn - 5) * HALF + jj0; *(u32x4*)dst = pack8(h0[0] * h1[0], h0[1] * h1[1]); }
                else { bf16_t* dst = (pn < 13 ? SGA + (size_t)r * D + (pn - 9) * BM : SGB + (size_t)r * D + (pn - 13) * BM) + jj0;
#pragma unroll
                    for (int n = 0; n < 2; ++n)
#pragma unroll
                        for (int e = 0; e < 4; ++e) { h0[n][e] = sigmoid_f(h0[n][e]); h1[n][e] = sigmoid_f(h1[n][e]); }
                    *(u32x4*)dst = pack8(h0[0], h0[1]); *(u32x4*)(dst + HALF) = pack8(h1[0], h1[1]); }
                if (m & 1) asm volatile("" ::: "memory"); }
    }
};
struct EpiMergeF {
    static constexpr bool PERM = true, AFTER_DRAIN = false; static constexpr int MID_T = 8;
    const bf16_t* SGA; const bf16_t* SGB; bf16_t* M;
    __device__ __forceinline__ void mid(f32x4 (&acc)[2][2][4][2], const Unit& u, int wr, int wc, int fr, int fq) const {
        const char* ga_b = (const char*)(SGA + (size_t)u.pm * BM * D); const char* gb_b = (const char*)(SGB + (size_t)u.pm * BM * D);
        const unsigned off0 = (unsigned)((wr * 64 + fr) * D + u.pn * BM + wc * 32 + 8 * fq) * 2u;
#pragma unroll
        for (int ai = 0; ai < 2; ++ai)
#pragma unroll
            for (int m = 0; m < 4; ++m) {
#pragma unroll
                for (int bj = 0; bj < 2; ++bj) { const unsigned off = off0 + (unsigned)((ai * HALF + m * 16) * D + bj * HALF) * 2u;
                    const u32x4 ga = *(const u32x4*)(ga_b + off), gb = *(const u32x4*)(gb_b + off);
                    f32x4 r0, r1;
                    r0[0] = bflo(ga.x) * fast_rcp(bflo(gb.x)); r0[1] = bfhi(ga.x) * fast_rcp(bfhi(gb.x)); r0[2] = bflo(ga.y) * fast_rcp(bflo(gb.y)); r0[3] = bfhi(ga.y) * fast_rcp(bfhi(gb.y));
                    r1[0] = bflo(ga.z) * fast_rcp(bflo(gb.z)); r1[1] = bfhi(ga.z) * fast_rcp(bfhi(gb.z)); r1[2] = bflo(ga.w) * fast_rcp(bflo(gb.w)); r1[3] = bfhi(ga.w) * fast_rcp(bfhi(gb.w));
                    acc[ai][bj][m][0] *= r0; acc[ai][bj][m][1] *= r1; }
                asm volatile("" ::: "memory"); }
    }
    __device__ __forceinline__ void operator()(const f32x4 (&acc)[2][2][4][2], const Unit& u, int wr, int wc, int fr, int fq) const {
        const char* gb_b = (const char*)(SGB + (size_t)u.pm * BM * D); char* m_b = (char*)(M + (size_t)u.pm * BM * D);
        const unsigned off0 = (unsigned)((wr * 64 + fr) * D + u.pn * BM + wc * 32 + 8 * fq) * 2u;
#pragma unroll
        for (int ai = 0; ai < 2; ++ai)
#pragma unroll
            for (int m = 0; m < 4; ++m) {
#pragma unroll
                for (int bj = 0; bj < 2; ++bj) { const unsigned off = off0 + (unsigned)((ai * HALF + m * 16) * D + bj * HALF) * 2u;
                    const u32x4 gb = *(const u32x4*)(gb_b + off);
                    const f32x4 g0 = (f32x4){bflo(gb.x), bfhi(gb.x), bflo(gb.y), bfhi(gb.y)}, g1 = (f32x4){bflo(gb.z), bfhi(gb.z), bflo(gb.w), bfhi(gb.w)};
                    *(u32x4*)(m_b + off) = pack8(acc[ai][bj][m][0] * g0, acc[ai][bj][m][1] * g1); }
                asm volatile("" ::: "memory"); }
    }
};

template <class Epi, class Sched, bool ALIGN_EPI = false, bool SP2 = false>
__device__ __forceinline__ void gemm_phase(PG8_LAS unsigned char* lds, const Gemm g, const Sched S, const Epi E) {
    int tid_o = threadIdx.x; asm volatile("" : "+v"(tid_o));
    const int tid = tid_o, wid = __builtin_amdgcn_readfirstlane(tid >> 6), lane = tid & 63, wr = wid >> 2, wc = wid & 3, fr = lane & 15, fq = lane >> 4;
    const int K = g.K, nt = K / BK;
    unsigned voffA[2], voffB[2];
#pragma unroll
    for (int i = 0; i < 2; ++i) { int R, C; stage_rc(tid * 16 + i * 8192, R, C); const int Rb = Epi::PERM ? ((R & ~31) + perm32(R & 31)) : R;
        voffA[i] = (unsigned)(R * K + C) * 2u; voffB[i] = (unsigned)(Rb * K + C) * 2u; }
    const size_t kstep = (size_t)(BK * 2);
    const size_t hstep = (size_t)HALF * K * 2;
    const size_t tstep = 2 * hstep;
    const unsigned ldsw = (unsigned)wid * 1024u;
    const int aoff = lds_byte(wr * 64 + fr, fq * 8), boff = lds_byte(wc * 32 + fr, fq * 8);
#define PG8_SA(b, h) (((b) * 2 + (h)) * HTB)
#define PG8_SB(b, h) ((4 + (b) * 2 + (h)) * HTB)
#define PG8_STAGE(bufoff, gbase, voff) do { _Pragma("unroll") for (int _i = 0; _i < 2; ++_i) \
        __builtin_amdgcn_global_load_lds((const unsigned*)((const char*)(gbase) + (voff)[_i]), (PG8_LAS unsigned*)(lds + (bufoff) + ldsw + _i * 8192), 16, 0, 0); } while (0)
#define PG8_LDA(dst, b, h) do { _Pragma("unroll") for (int m = 0; m < 4; ++m) _Pragma("unroll") for (int k = 0; k < 2; ++k) dst[m][k] = *(const PG8_LAS bf16x8*)(lds + PG8_SA(b, h) + aoff + m * 2048 + k * 1024); } while (0)
#define PG8_LDB(dst, b, h) do { _Pragma("unroll") for (int n = 0; n < 2; ++n) _Pragma("unroll") for (int k = 0; k < 2; ++k) dst[n][k] = *(const PG8_LAS bf16x8*)(lds + PG8_SB(b, h) + boff + n * 2048 + k * 1024); } while (0)
#define PG8_MMA(ai, bj, At, Bt) do { __builtin_amdgcn_s_setprio(1); _Pragma("unroll") for (int m = 0; m < 4; ++m) _Pragma("unroll") for (int n = 0; n < 2; ++n) _Pragma("unroll") for (int k = 0; k < 2; ++k) \
        acc[ai][bj][m][n] = __builtin_amdgcn_mfma_f32_16x16x32_bf16(Bt[n][k], At[m][k], acc[ai][bj][m][n], 0, 0, 0); __builtin_amdgcn_s_setprio(0); } while (0)
#define PG8_WAIT_V(n) asm volatile("s_waitcnt vmcnt(" #n ")" ::: "memory")
#define PG8_WAIT_L(n) asm volatile("s_waitcnt lgkmcnt(" #n ")" ::: "memory")
#define PG8_BAR __builtin_amdgcn_s_barrier()
#define PG8_SCHED __builtin_amdgcn_sched_barrier(0)
    Unit cur, nxt; int ui = 0;
    if (!S.next(0, cur)) return;
    f32x4 acc[2][2][4][2];
#pragma unroll
    for (int a = 0; a < 2; ++a)
#pragma unroll
        for (int b = 0; b < 2; ++b)
#pragma unroll
            for (int m = 0; m < 4; ++m)
#pragma unroll
                for (int n = 0; n < 2; ++n) acc[a][b][m][n] = (f32x4){0.f, 0.f, 0.f, 0.f};
    bf16x8 At[4][2], B0[2][2], B1[2][2];
    const char* cA = (const char*)g.A + (size_t)cur.pm * tstep; const char* cB = (const char*)g.Bt + (size_t)cur.pn * tstep;
    S.a_ready(cur);
    if constexpr (SP2) {
        PG8_STAGE(PG8_SB(0, 0), cB, voffB); PG8_STAGE(PG8_SB(0, 1), cB + hstep, voffB); PG8_STAGE(PG8_SA(0, 0), cA, voffA); PG8_STAGE(PG8_SA(0, 1), cA + hstep, voffA);
        if (wr == 1) PG8_BAR;
        PG8_WAIT_V(2); PG8_BAR;
        PG8_STAGE(PG8_SB(1, 0), cB + kstep, voffB); PG8_STAGE(PG8_SA(1, 0), cA + kstep, voffA); PG8_STAGE(PG8_SB(1, 1), cB + hstep + kstep, voffB);
        PG8_WAIT_V(6); PG8_BAR;
    } else {
        PG8_STAGE(PG8_SB(0, 0), cB, voffB); PG8_STAGE(PG8_SA(0, 0), cA, voffA); PG8_STAGE(PG8_SB(0, 1), cB + hstep, voffB); PG8_STAGE(PG8_SA(0, 1), cA + hstep, voffA);
        if (wr == 1) PG8_BAR;
        PG8_WAIT_V(4); PG8_BAR;
        PG8_STAGE(PG8_SB(1, 0), cB + kstep, voffB); PG8_STAGE(PG8_SA(1, 0), cA + kstep, voffA); PG8_STAGE(PG8_SB(1, 1), cB + hstep + kstep, voffB);
        PG8_WAIT_V(6); PG8_BAR;
    }
    for (;;) {
        const bool has_next = S.next(ui + 1, nxt);
        const char* nA = has_next ? (const char*)g.A + (size_t)nxt.pm * tstep : cA; const char* nB = has_next ? (const char*)g.Bt + (size_t)nxt.pn * tstep : cB;
        constexpr int NSEG = Epi::MID_T > 0 ? 2 : 1;
#pragma unroll
        for (int sg = 0; sg < NSEG; ++sg) {
        const int t_lo = sg == 0 ? 0 : Epi::MID_T, t_hi = (NSEG == 2 && sg == 0) ? Epi::MID_T : nt;
        if constexpr (NSEG == 2) { if (sg == 1) { int fr_e = fr, fq_e = fq; asm volatile("" : "+v"(fr_e), "+v"(fq_e)); E.mid(acc, cur, wr, wc, fr_e, fq_e); } }
        for (int t = t_lo; t < t_hi; t += 2) {
            const bool last = (t == nt - 2);
            const char* a1 = cA + (size_t)(t + 1) * kstep;
            const char* a2 = last ? nA : cA + (size_t)(t + 2) * kstep; const char* b2 = last ? nB : cB + (size_t)(t + 2) * kstep;
            const char* a3 = a2 + kstep; const char* b3 = b2 + kstep;
            if (last && has_next) S.a_ready(nxt);
            if constexpr (SP2) {
            PG8_LDB(B0, 0, 0); PG8_LDB(B1, 0, 1); PG8_SCHED; PG8_LDA(At, 0, 0); PG8_STAGE(PG8_SA(1, 1), a1 + hstep, voffA);
            PG8_WAIT_V(8); PG8_WAIT_L(0); PG8_BAR; PG8_MMA(0, 0, At, B0); PG8_MMA(0, 1, At, B1); PG8_BAR; PG8_SCHED;
            PG8_LDA(At, 0, 1); PG8_STAGE(PG8_SB(0, 0), b2, voffB); PG8_STAGE(PG8_SB(0, 1), b2 + hstep, voffB); PG8_STAGE(PG8_SA(0, 0), a2, voffA);
            PG8_WAIT_V(8); PG8_WAIT_L(0); PG8_BAR; PG8_MMA(1, 0, At, B0); PG8_MMA(1, 1, At, B1); PG8_BAR; PG8_SCHED;
            PG8_LDB(B0, 1, 0); PG8_LDB(B1, 1, 1); PG8_SCHED; PG8_LDA(At, 1, 0); PG8_STAGE(PG8_SA(0, 1), a2 + hstep, voffA);
            PG8_WAIT_V(8); PG8_WAIT_L(0); PG8_BAR; PG8_MMA(0, 0, At, B0); PG8_MMA(0, 1, At, B1); PG8_BAR; PG8_SCHED;
            PG8_LDA(At, 1, 1); PG8_STAGE(PG8_SB(1, 0), b3, voffB); PG8_STAGE(PG8_SB(1, 1), b3 + hstep, voffB); PG8_STAGE(PG8_SA(1, 0), a3, voffA);
            PG8_WAIT_V(8); PG8_WAIT_L(0); PG8_BAR; PG8_MMA(1, 0, At, B0); PG8_MMA(1, 1, At, B1); PG8_BAR; PG8_SCHED;
            } else {
            PG8_LDB(B0, 0, 0); PG8_SCHED; PG8_LDA(At, 0, 0); PG8_STAGE(PG8_SA(1, 1), a1 + hstep, voffA);
            PG8_WAIT_L(8); PG8_BAR; PG8_WAIT_L(0); PG8_MMA(0, 0, At, B0); PG8_BAR; PG8_SCHED;
            PG8_LDB(B1, 0, 1); PG8_STAGE(PG8_SB(0, 0), b2, voffB);
            PG8_BAR; PG8_WAIT_L(0); PG8_MMA(0, 1, At, B1); PG8_BAR;
            PG8_LDA(At, 0, 1); PG8_STAGE(PG8_SA(0, 0), a2, voffA);
            PG8_BAR; PG8_WAIT_L(0); PG8_MMA(1, 0, At, B0); PG8_BAR; PG8_SCHED;
            PG8_STAGE(PG8_SB(0, 1), b2 + hstep, voffB);
            PG8_WAIT_V(6); PG8_BAR; PG8_MMA(1, 1, At, B1); PG8_BAR;
            PG8_LDB(B0, 1, 0); PG8_SCHED; PG8_LDA(At, 1, 0); PG8_STAGE(PG8_SA(0, 1), a2 + hstep, voffA);
            PG8_WAIT_L(8); PG8_BAR; PG8_WAIT_L(0); PG8_MMA(0, 0, At, B0); PG8_BAR; PG8_SCHED;
            PG8_LDB(B1, 1, 1); PG8_STAGE(PG8_SB(1, 0), b3, voffB);
            PG8_BAR; PG8_WAIT_L(0); PG8_MMA(0, 1, At, B1); PG8_BAR;
            PG8_LDA(At, 1, 1); PG8_STAGE(PG8_SA(1, 0), a3, voffA);
            PG8_BAR; PG8_WAIT_L(0); PG8_MMA(1, 0, At, B0); PG8_BAR; PG8_SCHED;
            PG8_STAGE(PG8_SB(1, 1), b3 + hstep, voffB);
            PG8_WAIT_V(6); PG8_BAR; PG8_MMA(1, 1, At, B1); PG8_BAR;
            }
        }
        }
        if constexpr (ALIGN_EPI) { if (wr == 0) PG8_BAR; }
        if constexpr (!Epi::AFTER_DRAIN) { int fr_e = fr, fq_e = fq; asm volatile("" : "+v"(fr_e), "+v"(fq_e)); E(acc, cur, wr, wc, fr_e, fq_e); S.done(cur); }
        if (!has_next) break;
#pragma unroll
        for (int a = 0; a < 2; ++a)
#pragma unroll
            for (int b = 0; b < 2; ++b)
#pragma unroll
                for (int m = 0; m < 4; ++m)
#pragma unroll
                    for (int n = 0; n < 2; ++n) acc[a][b][m][n] = (f32x4){0.f, 0.f, 0.f, 0.f};
        cur = nxt; cA = nA; cB = nB; ++ui;
        if constexpr (ALIGN_EPI) { if (wr == 1) PG8_BAR; }
    }
    PG8_WAIT_V(0);
    if constexpr (!ALIGN_EPI) { if (wr == 0) PG8_BAR; }
    PG8_BAR;
    if constexpr (Epi::AFTER_DRAIN) { E.fused(acc, cur, wr, wc, fr, fq, lds, wid, lane); S.done(cur); }
#undef PG8_SA
#undef PG8_SB
#undef PG8_STAGE
#undef PG8_LDA
#undef PG8_LDB
#undef PG8_MMA
#undef PG8_WAIT_V
#undef PG8_WAIT_L
#undef PG8_BAR
#undef PG8_SCHED
}

}

#define XB_TMO      128
#define XB_XCNT(j)  (256  + 64 * (j))
#define XB_XSUB(j)  (1280 + 64 * (j))
#define XB_XGEN(j)  (2304 + 64 * (j))
#define XB_TOP      3328
#define XB_TOPGEN   3392
#define XCD_BAR_WORDS 3456
#define XB_SPIN_CAP (1u << 18)

__device__ __forceinline__ unsigned xb_ld(unsigned* p)              { return __hip_atomic_load(p, __ATOMIC_RELAXED, __HIP_MEMORY_SCOPE_AGENT); }
__device__ __forceinline__ unsigned xb_add(unsigned* p, unsigned v) { return __hip_atomic_fetch_add(p, v, __ATOMIC_RELAXED, __HIP_MEMORY_SCOPE_AGENT); }
__device__ __forceinline__ unsigned xb_xcc_id() { return (unsigned)__builtin_amdgcn_s_getreg((3 << 11) | 20) & 0xFu; }
#define XB_SPIN(cond, bar) do { unsigned _sp = 0; while (cond) { __builtin_amdgcn_s_sleep(1); \
    if ((++_sp & 255u) == 0u) { if (xb_ld(&(bar)[XB_TMO])) break; if (_sp > XB_SPIN_CAP) { atomicAdd(&(bar)[XB_TMO], 1u); break; } } } } while (0)

struct XcdBarrier {
    unsigned* bar; unsigned x;
    volatile LAS unsigned* st;
};

__device__ __forceinline__ XcdBarrier xcd_barrier_post(unsigned* bar, volatile LAS unsigned* st) {
    XcdBarrier b; b.bar = bar; b.x = xb_xcc_id(); b.st = st;
    if (threadIdx.x == 0) (void)xb_add(&bar[XB_XCNT(b.x)], 1u);
    return b;
}
__device__ __forceinline__ void xcd_barrier_complete(unsigned* bar, unsigned x, unsigned& nloc, unsigned& nx) {
    const unsigned G = gridDim.x * gridDim.y * gridDim.z;
    unsigned sum, cnt, mine, sp = 0u;
    for (;;) {
        sum = 0u; cnt = 0u; mine = 0u;
#pragma unroll
        for (unsigned j = 0; j < 16; ++j) { const unsigned c = xb_ld(&bar[XB_XCNT(j)]); sum += c; cnt += (c > 0u) ? 1u : 0u; mine = (j == x) ? c : mine; }
        if (sum == G) break;
        __builtin_amdgcn_s_sleep(1);
        if ((++sp & 255u) == 0u) { if (xb_ld(&bar[XB_TMO])) break; if (sp > XB_SPIN_CAP) { atomicAdd(&bar[XB_TMO], 1u); break; } }
    }
    nloc = mine > 0u ? mine : 1u; nx = cnt > 0u ? cnt : 1u;
}

__device__ __forceinline__ void xcd_barrier(const XcdBarrier& b) {
    asm volatile("s_waitcnt vmcnt(0)" ::: "memory");
    __syncthreads();
    if (threadIdx.x == 0) {
        unsigned long long bar_o = (unsigned long long)b.bar; unsigned bx_o = b.x; asm volatile("" : "+s"(bar_o), "+s"(bx_o));
        unsigned* bar = (unsigned*)bar_o; XcdBarrier bb; bb.bar = bar; bb.x = bx_o; bb.st = b.st; const XcdBarrier& b = bb;
        __builtin_amdgcn_s_waitcnt(0);
        unsigned nloc = b.st[0], nx = b.st[1];
        if (nloc == 0u) { xcd_barrier_complete(bar, b.x, nloc, nx); b.st[0] = nloc; b.st[1] = nx; }
        const unsigned old = xb_add(&bar[XB_XSUB(b.x)], 1u);
        const unsigned gen = old / nloc;
        if (old + 1u == (gen + 1u) * nloc) {
            __builtin_amdgcn_fence(__ATOMIC_RELEASE, "agent");
            asm volatile("s_waitcnt vmcnt(0)" ::: "memory");
            const unsigned og = xb_add(&bar[XB_TOP], 1u);
            const unsigned tg = og / nx;
            if (og + 1u == (tg + 1u) * nx) xb_add(&bar[XB_TOPGEN], 1u);
            else XB_SPIN(xb_ld(&bar[XB_TOPGEN]) == tg, bar);
            __builtin_amdgcn_fence(__ATOMIC_ACQUIRE, "agent");
            xb_add(&bar[XB_XGEN(b.x)], 1u);
            asm volatile("s_waitcnt vmcnt(0)" ::: "memory");
        } else {
            XB_SPIN(xb_ld(&bar[XB_XGEN(b.x)]) == gen, bar);
            __builtin_amdgcn_fence(__ATOMIC_ACQUIRE, "agent");
            asm volatile("s_waitcnt vmcnt(0)" ::: "memory");
        }
    }
    __syncthreads();
}


typedef float f32x4 __attribute__((ext_vector_type(4)));
typedef unsigned u32x4 __attribute__((ext_vector_type(4)));
#define LDS_WAIT() asm volatile("s_waitcnt lgkmcnt(0)" ::: "memory")

struct Args { const float* in[18]; float* out; unsigned char* ws; };

__device__ __forceinline__ void p0a_mod(const float* c, const float* c_ctx, const float* w_ada, const float* b_ada, float* mod, LAS float* scr, int gw, int ngw, int lane) {
    for (int it = gw; it < DEPTH * 36 * 16; it += ngw) {
        const int ks = it & 15, cb = (it >> 4) % 36, l = it / 576, k = ks * 64 + lane;
        { const float v0 = c[k], v1 = c[D + k], v2 = c_ctx[k]; scr[lane] = v0 * sigmoid_f(v0); scr[64 + lane] = v1 * sigmoid_f(v1); scr[128 + lane] = v2 * sigmoid_f(v2); }
        LDS_WAIT();
        const float* w = w_ada + ((size_t)l * D + ks * 64) * MODS + cb * 256 + lane * 4;
        f32x4 a0 = {0.f, 0.f, 0.f, 0.f}, a1 = a0, a2 = a0;
#pragma unroll 8
        for (int kk = 0; kk < 64; ++kk) { const f32x4 wv = *(const f32x4*)(w + (size_t)kk * MODS); a0 += wv * scr[kk]; a1 += wv * scr[64 + kk]; a2 += wv * scr[128 + kk]; }
        if (ks == 0) { const f32x4 bb = *(const f32x4*)(b_ada + l * MODS + cb * 256 + lane * 4); a0 += bb; a1 += bb; a2 += bb; }
        float* m0 = mod + (size_t)(l * 3) * MODS + cb * 256 + lane * 4;
#pragma unroll
        for (int e = 0; e < 4; ++e) { __hip_atomic_fetch_add(m0 + e, a0[e], __ATOMIC_RELAXED, __HIP_MEMORY_SCOPE_AGENT); __hip_atomic_fetch_add(m0 + MODS + e, a1[e], __ATOMIC_RELAXED, __HIP_MEMORY_SCOPE_AGENT);
                                      __hip_atomic_fetch_add(m0 + 2 * MODS + e, a2[e], __ATOMIC_RELAXED, __HIP_MEMORY_SCOPE_AGENT); }
        LDS_WAIT();
    }
}
__device__ __forceinline__ void p0a_rope(float* rope, int tid) {
    for (int i = tid; i < 128 * 16; i += NWAVES * 64) {
        const int pos = i >> 4, f = i & 15;
        const float inv = exp2f(-(float)f * (13.287712379549449f / 16.0f));
        const float ang = (float)pos * inv;
        const double rev = (double)ang * 0.15915494309189535; const float fr = (float)(rev - floor(rev));
        rope[2 * i] = __builtin_amdgcn_cosf(fr); rope[2 * i + 1] = __builtin_amdgcn_sinf(fr);
    }
}
__device__ __forceinline__ void p0_transpose_item(const float* W, int K, int N, int Nd, bf16* dst, int ldk, int koff, int map, LAS float* scr, int item, int lane) {
    const int nblk = Nd / 32, kb = item / nblk, nb = item % nblk, k0 = 64 * kb, n0 = 32 * nb;
    const int sc = src_col(map, n0 + (lane & 31));
#pragma unroll 8
    for (int i = 0; i < 32; ++i) { const int kk = 2 * i + (lane >> 5); scr[kk * 33 + (lane & 31)] = W[(size_t)(k0 + kk) * N + sc]; }
    LDS_WAIT(); asm volatile("" ::: "memory");
    const int c = lane & 7;
#pragma unroll
    for (int j = 0; j < 4; ++j) { const int n = (lane >> 3) + 8 * j; const LAS float* s = scr + (8 * c) * 33 + n;
        u32x4 o; o.x = pk2(s[0 * 33], s[1 * 33]); o.y = pk2(s[2 * 33], s[3 * 33]); o.z = pk2(s[4 * 33], s[5 * 33]); o.w = pk2(s[6 * 33], s[7 * 33]);
        *(u32x4*)(dst + (size_t)(n0 + n) * ldk + koff + k0 + 8 * c) = o; }
    LDS_WAIT(); asm volatile("" ::: "memory");
}
constexpr int CI_WI = (D / 64) * (2 * DFF / 32), CI_WO = (DFF / 64) * (D / 32), CI_WIN = (D / 64) * (PROJ_W / 32), CI_WAB = (512 / 64) * (D / 32), CI_WOUT = (D / 64) * (D / 32);
constexpr int CI_LAYER = 2 * CI_WI + 2 * CI_WO + CI_WIN + 2 * CI_WAB + CI_WOUT;
__device__ __forceinline__ void p0a_convert(const __attribute__((address_space(4))) Args* ap, LAS float* scr, int gw, int ngw, int lane) {
    const __attribute__((address_space(4))) Args& a = *ap;
    for (int it = gw; it < DEPTH * CI_LAYER; it += ngw) {
        const int l = it / CI_LAYER; int r = it % CI_LAYER; unsigned char* wl = a.ws + WS_W + (size_t)l * W_LAYER;
        if (r < CI_WI) { p0_transpose_item(a.in[7] + (size_t)l * D * 2 * DFF, D, 2 * DFF, 2 * DFF, (bf16*)(wl + W_WI1), D, 0, 1, scr, r, lane); continue; } r -= CI_WI;
        if (r < CI_WO) { p0_transpose_item(a.in[8] + (size_t)l * DFF * D, DFF, D, D, (bf16*)(wl + W_WO1), DFF, 0, 0, scr, r, lane); continue; } r -= CI_WO;
        if (r < CI_WIN) { p0_transpose_item(a.in[9] + (size_t)l * D * PROJ_W, D, PROJ_W, PROJ_W, (bf16*)(wl + W_WIN), D, 0, 2, scr, r, lane); continue; } r -= CI_WIN;
        if (r < CI_WAB) { p0_transpose_item(a.in[12] + (size_t)l * 512 * D, 512, D, D, (bf16*)(wl + W_WM), D, 0, 0, scr, r, lane); continue; } r -= CI_WAB;
        if (r < CI_WAB) { p0_transpose_item(a.in[13] + (size_t)l * 512 * D, 512, D, D, (bf16*)(wl + W_WM), D, 512, 0, scr, r, lane); continue; } r -= CI_WAB;
        if (r < CI_WOUT) { p0_transpose_item(a.in[14] + (size_t)l * D * D, D, D, D, (bf16*)(wl + W_WOUT), D, 0, 0, scr, r, lane); continue; } r -= CI_WOUT;
        if (r < CI_WI) { p0_transpose_item(a.in[15] + (size_t)l * D * 2 * DFF, D, 2 * DFF, 2 * DFF, (bf16*)(wl + W_WI2), D, 0, 1, scr, r, lane); continue; } r -= CI_WI;
        p0_transpose_item(a.in[16] + (size_t)l * DFF * D, DFF, D, D, (bf16*)(wl + W_WO2), DFF, 0, 0, scr, r, lane);
    }
}
__device__ __forceinline__ void p0b_rows(const float* x, const float* ctx, float* XL, float* XCp, const float* nw, const float* mod0  , bf16* XT, float* ssq, int gw, int ngw, int lane) {
    for (int r = gw; r < R; r += ngw) {
        const float* src = r < ML ? x + (size_t)r * D : ctx + (size_t)(r - ML) * D; float* dst = r < ML ? XL + (size_t)r * D : XCp + (size_t)(r - ML) * D;
        const int set = r < SEQ ? 0 : (r < ML ? 1 : 2); const float* scl = mod0 + set * MODS + 1 * D;
        float ss = 0.f;
#pragma unroll
        for (int j = 0; j < 4; ++j) { const int k = 256 * j + 4 * lane; const f32x4 v = *(const f32x4*)(src + k); *(f32x4*)(dst + k) = v; ss += (v[0] * v[0] + v[1] * v[1]) + (v[2] * v[2] + v[3] * v[3]);
            const f32x4 t = v * (*(const f32x4*)(nw + k)) * (*(const f32x4*)(scl + k) + 1.0f); u32x2 w; w.x = pk2(t[0], t[1]); w.y = pk2(t[2], t[3]); *(u32x2*)(XT + (size_t)r * D + k) = w; }
        ss = wave_sum(ss);
        if (lane < 16) ssq[(size_t)r * 16 + lane] = lane == 0 ? ss : 0.f;
    }
}
__device__ __forceinline__ void p0b_sw(const unsigned char* ws, const float* mod, float* sw, int gw, int ngw, int lane) {
    constexpr int NR = 2 * DFF + PROJ_W + 2 * DFF;
    for (int it = gw; it < DEPTH * NR; it += ngw) {
        const int l = it / NR; int n = it % NR; int s, ish; const unsigned char* wl = ws + WS_W + (size_t)l * W_LAYER; const bf16* bt;
        if (n < 2 * DFF) { s = 0; ish = 0; bt = (const bf16*)(wl + W_WI1); } else if (n < 2 * DFF + PROJ_W) { n -= 2 * DFF; s = 1; ish = 3; bt = (const bf16*)(wl + W_WIN); } else { n -= 2 * DFF + PROJ_W; s = 2; ish = 6; bt = (const bf16*)(wl + W_WI2); }
        const u32x4 w0 = *(const u32x4*)(bt + (size_t)n * D + 8 * lane), w1 = *(const u32x4*)(bt + (size_t)n * D + 512 + 8 * lane);
        float wv[16] = {bflo(w0.x), bfhi(w0.x), bflo(w0.y), bfhi(w0.y), bflo(w0.z), bfhi(w0.z), bflo(w0.w), bfhi(w0.w), bflo(w1.x), bfhi(w1.x), bflo(w1.y), bfhi(w1.y), bflo(w1.z), bfhi(w1.z), bflo(w1.w), bfhi(w1.w)};
#pragma unroll
        for (int set = 0; set < 3; ++set) { const float* sh = mod + (size_t)(l * 3 + set) * MODS + ish * D; float acc = 0.f;
#pragma unroll
            for (int h = 0; h < 2; ++h) { const f32x4 a = *(const f32x4*)(sh + 512 * h + 8 * lane), b = *(const f32x4*)(sh + 512 * h + 8 * lane + 4);
                acc += a[0] * wv[8 * h] + a[1] * wv[8 * h + 1] + a[2] * wv[8 * h + 2] + a[3] * wv[8 * h + 3] + b[0] * wv[8 * h + 4] + b[1] * wv[8 * h + 5] + b[2] * wv[8 * h + 6] + b[3] * wv[8 * h + 7]; }
            acc = wave_sum(acc);
            if (lane == 0) sw[(size_t)((l * 3 + s) * 3 + set) * SWN + n] = acc; }
    }
}
__device__ __forceinline__ void attn_simple_phase(LAS unsigned char* lds, const bf16* Q, const bf16* K, const bf16* V, const float* sink, bf16* OY, int nrows, int G, int bx, int wave, int lane) {
    const int hw = wave >> 2, w4 = wave & 3;
    LAS float* qs = (LAS float*)lds + (hw * 4 + w4) * 64; LAS float* ps = (LAS float*)(lds + 4096) + (hw * 4 + w4) * 640;
    for (int base = 0; base < nrows * 2; base += 2 * G) {
        const int item = base + bx * 2 + hw; const bool act = item < nrows * 2;
        const int r = act ? item >> 1 : 0, kh = item & 1, h = kh * 4 + w4;
        __syncthreads();
        qs[lane] = bf2f(Q[(size_t)r * 512 + h * 64 + lane]);
        const bool lat = r < ML; const int b = lat ? r / SEQ : (r - ML) / CTX, t = lat ? r % SEQ : 0, n = t >> 7; const int nslots = lat ? 640 : 256;
        __syncthreads();
        float mx = -3.0e38f;
#pragma unroll 1
        for (int i = 0; i < 10; ++i) { const int s = lane + 64 * i; bool valid = false; int krow = 0;
            if (s < 256) { krow = ML + b * CTX + s; valid = true; }
            else if (lat) { const int kpos = (n - 1) * 128 + (s - 256), dlt = kpos - t; valid = kpos >= 0 && kpos < SEQ && dlt <= 128 && dlt >= -128; krow = b * SEQ + kpos; }
            float dot = -3.0e38f;
            if (valid) { dot = 0.f; const u32x4* kp = (const u32x4*)(K + (size_t)krow * 128 + kh * 64);
#pragma unroll 2
                for (int d8 = 0; d8 < 8; ++d8) { const u32x4 kv = kp[d8]; const LAS float* q = qs + 8 * d8;
                    dot += q[0] * bflo(kv.x) + q[1] * bfhi(kv.x) + q[2] * bflo(kv.y) + q[3] * bfhi(kv.y) + q[4] * bflo(kv.z) + q[5] * bfhi(kv.z) + q[6] * bflo(kv.w) + q[7] * bfhi(kv.w); } }
            ps[s] = dot; mx = fmaxf(mx, dot); }
        const float sk = sink[h] * LOG2E;
        mx = fmaxf(wave_max(mx), sk);
        float lsum = 0.f;
#pragma unroll 1
        for (int i = 0; i < 10; ++i) { const int s = lane + 64 * i; const float v = ps[s]; const float p = v > -1.0e38f ? exp2f(v - mx) : 0.f; ps[s] = p; lsum += p; }
        lsum = wave_sum(lsum) + exp2f(sk - mx);
        __syncthreads();
        float o = 0.f;
        for (int s = 0; s < nslots; ++s) { const float p = ps[s]; if (p != 0.f) { const int krow = s < 256 ? ML + b * CTX + s : b * SEQ + (n - 1) * 128 + (s - 256); o += p * bf2f(V[(size_t)krow * 128 + kh * 64 + lane]); } }
        if (act) OY[(size_t)r * D + h * 64 + lane] = (bf16)f2bf(o / lsum);
    }
}
__device__ __forceinline__ void conv_phase(const bf16* ZB, const bf16* P, const float* cw, bf16* OY, int nrows, int gt, int ngt) {
    for (int g = gt; g < nrows * 64; g += ngt) {
        const int r = g >> 6, j = (g & 63) * 8;
        bool first, last; if (r < ML) { const int t = r & (SEQ - 1); first = t == 0; last = t == SEQ - 1; } else { const int l = (r - ML) & (CTX - 1); first = l == 0; last = l == CTX - 1; }
        const u32x4 z = *(const u32x4*)(ZB + (size_t)r * 512 + j), p0 = *(const u32x4*)(P + (size_t)r * 512 + j);
        u32x4 pm = {0u, 0u, 0u, 0u}, pp = {0u, 0u, 0u, 0u};
        if (!first) pm = *(const u32x4*)(P + (size_t)(r - 1) * 512 + j);
        if (!last) pp = *(const u32x4*)(P + (size_t)(r + 1) * 512 + j);
        const f32x4 w0a = *(const f32x4*)(cw + j), w0b = *(const f32x4*)(cw + j + 4), w1a = *(const f32x4*)(cw + 512 + j), w1b = *(const f32x4*)(cw + 512 + j + 4), w2a = *(const f32x4*)(cw + 1024 + j), w2b = *(const f32x4*)(cw + 1024 + j + 4);
        u32x4 o;
#define CONV2(W, I0, WA, I1) o.W = pk2(bflo(z.W) * (WA##0[I0] * bflo(pm.W) + WA##1[I0] * bflo(p0.W) + WA##2[I0] * bflo(pp.W)), bfhi(z.W) * (WA##0[I1] * bfhi(pm.W) + WA##1[I1] * bfhi(p0.W) + WA##2[I1] * bfhi(pp.W)))
        { const f32x4 A0 = w0a, A1 = w1a, A2 = w2a, B0 = w0b, B1 = w1b, B2 = w2b;
          CONV2(x, 0, A, 1); CONV2(y, 2, A, 3); CONV2(z, 0, B, 1); CONV2(w, 2, B, 3); }
#undef CONV2
        *(u32x4*)(OY + (size_t)r * D + 512 + j) = o;
    }
}
__device__ __forceinline__ void final_phase(float* XL, const float* ssq, const float* fw, int gw, int ngw, int lane) {
    for (int r = gw; r < ML; r += ngw) {
        float s = lane < 16 ? ssq[(size_t)r * 16 + lane] : 0.f; s = wave_sum(s);
        const float rstd = rsqrtf(s * (1.0f / D) + EPS); float* x = XL + (size_t)r * D;
#pragma unroll
        for (int j = 0; j < 4; ++j) { const int k = 256 * j + 4 * lane; *(f32x4*)(x + k) = *(const f32x4*)(x + k) * rstd * (*(const f32x4*)(fw + k)); }
    }
}

typedef const __attribute__((address_space(4))) Args* KArgs;
__device__ __forceinline__ KArgs fresh_args() { unsigned long long p = (unsigned long long)__builtin_amdgcn_kernarg_segment_ptr(); asm volatile("" : "+s"(p)); return (KArgs)p; }
#define WSP(T, off) ((T*)(ws + (off)))

__global__ void __launch_bounds__(NWAVES * 64, 2) mk_fwd(Args a_unused) {
    extern __shared__ __attribute__((aligned(16))) unsigned char lds_raw[];
    LAS unsigned char* lds = (LAS unsigned char*)lds_raw;
    const int G = gridDim.x, bx = blockIdx.x;
    { const int tid = threadIdx.x; for (int u = tid; u < (LDS_BYTES - RING_BYTES) / 4; u += NWAVES * 64) ((LAS unsigned*)(lds + RING_BYTES))[u] = 0u; }
    __syncthreads();
    XcdBarrier bar;
    { unsigned char* ws = fresh_args()->ws; bar = xcd_barrier_post((unsigned*)(ws + WS_CTL) + 4096, (volatile LAS unsigned*)(lds + MISC_OFF) + 8); }

    { KArgs A = fresh_args(); unsigned char* ws = A->ws; int tid_o = threadIdx.x; asm volatile("" : "+v"(tid_o)); const int tid = tid_o, lane = tid & 63, wave = __builtin_amdgcn_readfirstlane(tid >> 6), gw = bx * NWAVES + wave, ngw = G * NWAVES;
      LAS float* scr = (LAS float*)(lds + wave * 16384);
      p0a_mod(A->in[1], A->in[3], A->in[4], A->in[5], WSP(float, WS_MOD), scr, gw, ngw, lane);
      if (bx == G - 1) p0a_rope(WSP(float, WS_ROPE), tid);
      p0a_convert(A, scr, gw, ngw, lane); }
    xcd_barrier(bar);
    { KArgs A = fresh_args(); unsigned char* ws = A->ws; int tid_o = threadIdx.x; asm volatile("" : "+v"(tid_o)); const int tid = tid_o, lane = tid & 63, wave = __builtin_amdgcn_readfirstlane(tid >> 6), gw = bx * NWAVES + wave, ngw = G * NWAVES;
      p0b_rows(A->in[0], A->in[2], A->out, WSP(float, WS_XC), A->in[6], WSP(float, WS_MOD), WSP(bf16, WS_XT), WSP(float, WS_SSQ), gw, ngw, lane);
      p0b_sw(ws, WSP(float, WS_MOD), WSP(float, WS_SW), gw, ngw, lane); }
    xcd_barrier(bar);

    for (int l = 0; l < DEPTH; ++l) {
        const bool last = l == DEPTH - 1;
        const int Mrows = last ? ML : R;
        for (int f = 0; f < 2; ++f) {
            const int Mf = (f == 1) ? Mrows : R;
            { KArgs A = fresh_args(); unsigned char* ws = A->ws; const unsigned char* wl = ws + WS_W + (size_t)l * W_LAYER; int bxo = bx; asm volatile("" : "+s"(bxo));
              pg8::Gemm g{WSP(bf16, WS_XT), (const bf16*)(wl + (f ? W_WI2 : W_WI1)), Mf, 2 * DFF, D}; pg8::StaticOrder S; S.init(Mf, 2 * DFF, G, bxo);
              pg8::EpiSwigluF E{WSP(bf16, WS_U + U_ACT), WSP(float, WS_SSQ), WSP(float, WS_SW) + (size_t)(l * 9 + (f ? 6 : 0)) * SWN};
              pg8::gemm_phase<pg8::EpiSwigluF, pg8::StaticOrder, true, true>(lds, g, S, E); }
            xcd_barrier(bar);
            { KArgs A = fresh_args(); unsigned char* ws = A->ws; const unsigned char* wl = ws + WS_W + (size_t)l * W_LAYER; int bxo = bx; asm volatile("" : "+s"(bxo)); const float* modl = WSP(float, WS_MOD) + (size_t)l * 3 * MODS; const float* nw = A->in[6] + l * 3 * D;
              pg8::Gemm g{WSP(bf16, WS_U + U_ACT), (const bf16*)(wl + (f ? W_WO2 : W_WO1)), Mf, D, DFF}; pg8::StaticOrder S; S.init(Mf, D, G, bxo);
              const float* nwn; const float* scn;
              if (f == 0) { nwn = nw + D; scn = modl + 4 * D; } else if (!last) { nwn = nw + 3 * D; scn = modl + 3 * MODS + 1 * D; } else { nwn = nw; scn = modl; }
              pg8::EpiResidF<1> E{A->out, WSP(float, WS_XC), modl + (f ? 8 : 2) * D, nwn, scn, WSP(bf16, WS_XT), WSP(float, WS_SSQ)};
              pg8::gemm_phase<pg8::EpiResidF<1>, pg8::StaticOrder, true, true>(lds, g, S, E); }
            xcd_barrier(bar);
            if (f == 1) break;
            { KArgs A = fresh_args(); unsigned char* ws = A->ws; const unsigned char* wl = ws + WS_W + (size_t)l * W_LAYER; int bxo = bx; asm volatile("" : "+s"(bxo)); unsigned char* U = ws + WS_U;
              pg8::Gemm g{WSP(bf16, WS_XT), (const bf16*)(wl + W_WIN), R, PROJ_W, D}; pg8::StaticOrder S; S.init(R, PROJ_W, G, bxo);
              pg8::EpiWinF E{(bf16*)(U + U_Q), (bf16*)(U + U_K), (bf16*)(U + U_V), (bf16*)(U + U_ZB), (bf16*)(U + U_P), (bf16*)(U + U_SGA), (bf16*)(U + U_SGB), WSP(float, WS_ROPE), WSP(float, WS_SSQ), WSP(float, WS_SW) + (size_t)(l * 9 + 3) * SWN};
              pg8::gemm_phase<pg8::EpiWinF, pg8::StaticOrder, true, true>(lds, g, S, E); }
            xcd_barrier(bar);
            { KArgs A = fresh_args(); unsigned char* ws = A->ws; unsigned char* U = ws + WS_U; int tid_o = threadIdx.x; asm volatile("" : "+v"(tid_o)); const int tid = tid_o, lane = tid & 63, wave = __builtin_amdgcn_readfirstlane(tid >> 6);
              attn_simple_phase(lds, (const bf16*)(U + U_Q), (const bf16*)(U + U_K), (const bf16*)(U + U_V), A->in[11] + l * NH, (bf16*)(U + U_OY), Mrows, G, bx, wave, lane);
              conv_phase((const bf16*)(U + U_ZB), (const bf16*)(U + U_P), A->in[10] + l * 3 * 512, (bf16*)(U + U_OY), Mrows, bx * NWAVES * 64 + tid, G * NWAVES * 64); }
            xcd_barrier(bar);
            { KArgs A = fresh_args(); unsigned char* ws = A->ws; const unsigned char* wl = ws + WS_W + (size_t)l * W_LAYER; int bxo = bx; asm volatile("" : "+s"(bxo)); unsigned char* U = ws + WS_U;
              pg8::Gemm g{(const bf16*)(U + U_OY), (const bf16*)(wl + W_WM), Mrows, D, D}; pg8::StaticOrder S; S.init(Mrows, D, G, bxo);
              pg8::EpiMergeF E{(const bf16*)(U + U_SGA), (const bf16*)(U + U_SGB), (bf16*)(U + U_M)};
              pg8::gemm_phase<pg8::EpiMergeF, pg8::StaticOrder, true, true>(lds, g, S, E); }
            xcd_barrier(bar);
            { KArgs A = fresh_args(); unsigned char* ws = A->ws; const unsigned char* wl = ws + WS_W + (size_t)l * W_LAYER; int bxo = bx; asm volatile("" : "+s"(bxo)); const float* modl = WSP(float, WS_MOD) + (size_t)l * 3 * MODS; const float* nw = A->in[6] + l * 3 * D;
              pg8::Gemm g{WSP(bf16, WS_U + U_M), (const bf16*)(wl + W_WOUT), Mrows, D, D}; pg8::StaticOrder S; S.init(Mrows, D, G, bxo);
              pg8::EpiResidF<2> E{A->out, WSP(float, WS_XC), modl + 5 * D, nw + 2 * D, modl + 7 * D, WSP(bf16, WS_XT), WSP(float, WS_SSQ)};
              pg8::gemm_phase<pg8::EpiResidF<2>, pg8::StaticOrder, true, true>(lds, g, S, E); }
            xcd_barrier(bar);
        }
    }
    { KArgs A = fresh_args(); unsigned char* ws = A->ws; int tid_o = threadIdx.x; asm volatile("" : "+v"(tid_o)); const int tid = tid_o, lane = tid & 63, wave = __builtin_amdgcn_readfirstlane(tid >> 6);
      final_phase(A->out, WSP(float, WS_SSQ), A->in[17], bx * NWAVES + wave, G * NWAVES, lane); }
}

extern "C" void kernel_launch(void* const* d_in, const int* in_sizes, int n_in, void* d_out, int out_size, void* d_ws, size_t ws_size, hipStream_t stream) {
    static int grid = 0;
    if (grid == 0) {
        if (n_in != 18 || in_sizes[0] != ML * D || out_size != ML * D || ws_size < WS_END) { fprintf(stderr, "kernel_launch: unexpected shapes (n_in %d, in0 %d, out %d, ws %zu < %zu); nothing launched\n", n_in, n_in > 0 ? in_sizes[0] : -1, out_size, ws_size, (size_t)WS_END); grid = -1; return; }
        int dev = 0, cus = 0, per_cu = 0;
        if (hipGetDevice(&dev) != hipSuccess || hipDeviceGetAttribute(&cus, hipDeviceAttributeMultiprocessorCount, dev) != hipSuccess) { fprintf(stderr, "kernel_launch: device query failed\n"); grid = -1; return; }
        if (hipFuncSetAttribute((const void*)mk_fwd, hipFuncAttributeMaxDynamicSharedMemorySize, LDS_BYTES) != hipSuccess) { fprintf(stderr, "kernel_launch: hipFuncSetAttribute failed\n"); grid = -1; return; }
        if (hipOccupancyMaxActiveBlocksPerMultiprocessor(&per_cu, (const void*)mk_fwd, NWAVES * 64, LDS_BYTES) != hipSuccess || per_cu < 1) { fprintf(stderr, "kernel_launch: occupancy query says %d blocks per CU; nothing launched\n", per_cu); (void)hipGetLastError(); grid = -1; return; }
        grid = cus;
    }
    if (grid < 0) return;
    (void)hipMemsetAsync((char*)d_ws, 0, ZERO_BYTES, stream);
    Args a{};
    for (int i = 0; i < 18; ++i) a.in[i] = (const float*)d_in[i];
    a.out = (float*)d_out; a.ws = (unsigned char*)d_ws;
    hipLaunchKernelGGL(mk_fwd, dim3(grid), dim3(NWAVES * 64), LDS_BYTES, stream, a);
}
```

```cpp
#include <hip/hip_runtime.h>
#include <cstdio>
#include <cstdint>

#define LAS __attribute__((address_space(3)))
typedef unsigned short bf16;
typedef float f32x2 __attribute__((ext_vector_type(2)));
typedef unsigned u32x2 __attribute__((ext_vector_type(2)));

constexpr int D = 1024, BATCH = 2, SEQ = 8192, DEPTH = 2, CTX = 256, NH = 8, NKV = 2, HD = 64;
constexpr int DFF = 2816, NMOD = 9, PROJ_W = 4352;
constexpr int ML = BATCH * SEQ, MC = BATCH * CTX, R = ML + MC;
constexpr float EPS = 1e-6f;
constexpr float LOG2E = 1.4426950408889634f;
constexpr float QSCALE = 0.125f * LOG2E;
constexpr int MODS = NMOD * D;
constexpr int SWN = 2 * DFF;

constexpr size_t MiB = 1u << 20;
constexpr size_t WS_CTL = 0;
constexpr size_t WS_MOD = 1 * MiB;
constexpr size_t ZERO_BYTES = WS_MOD + 256 * 1024;
constexpr size_t WS_ROPE = WS_MOD + 256 * 1024;
constexpr size_t WS_SW = WS_MOD + 512 * 1024;
constexpr size_t WS_W = 2 * MiB;
constexpr size_t W_WI1 = 0, W_WO1 = W_WI1 + (size_t)2 * DFF * D * 2, W_WIN = W_WO1 + (size_t)D * DFF * 2, W_WM = W_WIN + (size_t)PROJ_W * D * 2,
                 W_WOUT = W_WM + (size_t)D * D * 2, W_WI2 = W_WOUT + (size_t)D * D * 2, W_WO2 = W_WI2 + (size_t)2 * DFF * D * 2, W_LAYER = W_WO2 + (size_t)D * DFF * 2;
static_assert(W_LAYER == (size_t)(45 * MiB + MiB / 2), "layer weights");
static_assert(WS_SW + (size_t)2 * 3 * 3 * SWN * 4 <= WS_W, "sW fits");
constexpr size_t WS_XC = WS_W + 2 * W_LAYER;
constexpr size_t WS_SSQ = WS_XC + 2 * MiB;
constexpr size_t WS_XT = WS_SSQ + 2 * MiB;
constexpr size_t WS_U = WS_XT + (size_t)R * D * 2;
constexpr size_t U_ACT = 0;
constexpr size_t U_Q = 0, U_K = U_Q + (size_t)R * 512 * 2, U_V = U_K + (size_t)R * 128 * 2, U_ZB = U_V + (size_t)R * 128 * 2, U_P = U_ZB + (size_t)R * 512 * 2,
                 U_SGA = U_P + (size_t)R * 512 * 2, U_SGB = U_SGA + (size_t)R * D * 2, U_OY = U_SGB + (size_t)R * D * 2, U_END = U_OY + (size_t)R * D * 2;
constexpr size_t U_M = U_ZB;
constexpr size_t WS_END = WS_U + U_END;
static_assert((size_t)R * DFF * 2 <= U_END && (size_t)R * 16 * 4 <= 2 * MiB, "ACT fits the union; SSQ fits");

constexpr int RING_BYTES = 131072;
constexpr int MISC_OFF = RING_BYTES + 320;
constexpr int LDS_BYTES = 147456;
constexpr int NWAVES = 8;

__device__ __forceinline__ unsigned f2bf(float f) { unsigned u = __builtin_bit_cast(unsigned, f); return (u + 0x7fffu + ((u >> 16) & 1u)) >> 16; }
__device__ __forceinline__ float bf2f(bf16 v) { return __builtin_bit_cast(float, (unsigned)v << 16); }
__device__ __forceinline__ float bflo(unsigned w) { return __builtin_bit_cast(float, w << 16); }
__device__ __forceinline__ float bfhi(unsigned w) { return __builtin_bit_cast(float, w & 0xffff0000u); }
__device__ __forceinline__ unsigned pk2(float lo, float hi) { return f2bf(lo) | (f2bf(hi) << 16); }
__device__ __forceinline__ float wave_sum(float v) {
#pragma unroll
    for (int o = 1; o < 64; o <<= 1) v += __shfl_xor(v, o);
    return v;
}
__device__ __forceinline__ float wave_max(float v) {
#pragma unroll
    for (int o = 1; o < 64; o <<= 1) v = fmaxf(v, __shfl_xor(v, o));
    return v;
}
__device__ __forceinline__ float fast_rcp(float x) { return __builtin_amdgcn_rcpf(x); }
__device__ __forceinline__ float fast_exp2(float x) { return __builtin_amdgcn_exp2f(x); }
__device__ __forceinline__ float sigmoid_f(float x) { return fast_rcp(1.f + fast_exp2(-x * LOG2E)); }

__host__ __device__ __forceinline__ int src_col(int map, int np) {
    if (map == 0) return np;
    const int pn = np >> 8, w = np & 255, half = w >> 7, jj = w & 127;
    if (map == 1) return half * DFF + pn * 128 + jj;
    if (pn < 2) { const int head = pn * 4 + (jj >> 5), i = jj & 31, d1 = i < 16 ? i : i + 16; return head * 64 + d1 + (half ? 16 : 0); }
    if (pn == 2) { if (jj < 64) { const int kvh = jj >> 5, i = jj & 31, d1 = i < 16 ? i : i + 16; return 512 + kvh * 64 + d1 + (half ? 16 : 0); }
                   return 640 + half * 64 + (jj - 64); }
    if (pn < 5) return 768 + (pn - 3) * 256 + w;
    if (pn < 9) return (half ? 1792 : 1280) + (pn - 5) * 128 + jj;
    if (pn < 13) return 2304 + (pn - 9) * 256 + w;
    return 3328 + (pn - 13) * 256 + w;
}


namespace pg8 {
#define PG8_LAS __attribute__((address_space(3)))
typedef unsigned short bf16_t;
typedef short bf16x8 __attribute__((ext_vector_type(8)));
typedef float f32x4 __attribute__((ext_vector_type(4)));
typedef unsigned u32x4 __attribute__((ext_vector_type(4)));

constexpr int BM = 256, BK = 64, HALF = 128, HTB = HALF * BK * 2  , STAGE_BYTES = 8 * HTB, NXCD = 8, WGM = 8;

__host__ __device__ __forceinline__ int lds_byte(int r, int c) { const int st = (r >> 4) * 2 + (c >> 5), rr = r & 15, cc = c & 31, ob = rr * 64 + cc * 2; return st * 1024 + (ob ^ (((ob >> 9) & 1) << 5)); }
__host__ __device__ __forceinline__ void stage_rc(int b, int& R, int& C) { const int st = b / 1024, sb = b % 1024, swz = sb ^ (((sb >> 9) & 1) << 5); R = (st >> 1) * 16 + swz / 64; C = (st & 1) * 32 + (swz % 64) / 2; }
__host__ __device__ __forceinline__ int perm32(int rho) { const int n = rho >> 4, i = rho & 15; return 8 * (i >> 2) + 4 * n + (i & 3); }

struct Unit { int pm, pn; };
struct Gemm { const bf16_t* A; const bf16_t* Bt; int M, N, K; };

struct StaticOrder {
    int nM, nN, nwg, G, c;
    __host__ __device__ void init(int M, int N, int G_, int c_) { nM = M / BM; nN = N / BM; nwg = nM * nN; G = G_; c = c_; }
    __host__ __device__ bool next(int i, Unit& u) const {
        const long L = (long)i * G + c; if (L >= nwg) return false;
        int wgid = (int)L; { const int q = nwg / NXCD, r = nwg % NXCD, xcd = wgid % NXCD, off = wgid / NXCD; wgid = (xcd < r ? xcd * (q + 1) : r * (q + 1) + (xcd - r) * q) + off; }
        const int nig = WGM * nN, gid = wgid / nig, fm = gid * WGM, gsz = (nM - fm) < WGM ? (nM - fm) : WGM;
        u.pm = fm + ((wgid % nig) % gsz); u.pn = (wgid % nig) / gsz; return true;
    }
    __device__ __forceinline__ void a_ready(const Unit&) const {}
    __device__ __forceinline__ void done(const Unit&) const {}
};

__device__ __forceinline__ unsigned cvt_pk_bf16(float lo, float hi) { unsigned r; asm volatile("v_cvt_pk_bf16_f32 %0, %1, %2" : "=v"(r) : "v"(lo), "v"(hi)); return r; }


__device__ __forceinline__ int tile_set(int pm) { return pm < 32 ? 0 : (pm < 64 ? 1 : 2); }
__device__ __forceinline__ float rstd_row(const float* ssq, int r) {
    const f32x4* p = (const f32x4*)(ssq + (size_t)r * 16); const f32x4 a = p[0], b = p[1], c = p[2], d = p[3];
    const float s = (((a[0] + a[1]) + (a[2] + a[3])) + ((b[0] + b[1]) + (b[2] + b[3]))) + (((c[0] + c[1]) + (c[2] + c[3])) + ((d[0] + d[1]) + (d[2] + d[3])));
    return rsqrtf(s * (1.0f / D) + EPS);
}
__device__ __forceinline__ u32x4 pack8(const f32x4& v0, const f32x4& v1) { u32x4 w; w.x = cvt_pk_bf16(v0[0], v0[1]); w.y = cvt_pk_bf16(v0[2], v0[3]); w.z = cvt_pk_bf16(v1[0], v1[1]); w.w = cvt_pk_bf16(v1[2], v1[3]); return w; }

struct EpiSwigluF {
    static constexpr bool PERM = true, AFTER_DRAIN = false; static constexpr int MID_T = 0;
    bf16_t* ACT; const float* ssq; const float* sw;
    __device__ __forceinline__ void mid(f32x4 (&)[2][2][4][2], const Unit&, int, int, int, int) const {}
    __device__ __forceinline__ void operator()(const f32x4 (&acc)[2][2][4][2], const Unit& u, int wr, int wc, int fr, int fq) const {
        const int set = tile_set(u.pm), row0 = u.pm * BM + wr * 64 + fr, jj0 = wc * 32 + 8 * fq;
        const float* swp = sw + set * SWN + u.pn * BM + jj0;
        f32x4 sa[2], sg[2];
#pragma unroll
        for (int n = 0; n < 2; ++n) { sa[n] = *(const f32x4*)(swp + 4 * n); sg[n] = *(const f32x4*)(swp + HALF + 4 * n); }
#pragma unroll
        for (int ai = 0; ai < 2; ++ai)
#pragma unroll
            for (int m = 0; m < 4; ++m) { const int r = row0 + ai * HALF + m * 16; const float rs = rstd_row(ssq, r); f32x4 o[2];
#pragma unroll
                for (int n = 0; n < 2; ++n) { const f32x4 av = acc[ai][0][m][n] * rs + sa[n], gv = acc[ai][1][m][n] * rs + sg[n];
#pragma unroll
                    for (int e = 0; e < 4; ++e) o[n][e] = av[e] * gv[e] * fast_rcp(1.f + fast_exp2(-gv[e] * LOG2E)); }
                *(u32x4*)(ACT + (size_t)r * DFF + u.pn * HALF + jj0) = pack8(o[0], o[1]);
                if (m & 1) asm volatile("" ::: "memory"); }
    }
};
template <int GS2> struct EpiResidF {
    static constexpr bool PERM = false, AFTER_DRAIN = false; static constexpr int MID_T = 0;
    float* XL; float* XCp; const float* gate; const float* nwn; const float* scn; bf16_t* XT; float* ssq;
    __device__ __forceinline__ void mid(f32x4 (&)[2][2][4][2], const Unit&, int, int, int, int) const {}
    __device__ __forceinline__ void operator()(const f32x4 (&acc)[2][2][4][2], const Unit& u, int wr, int wc, int fr, int fq) const {
        const int set = tile_set(u.pm), col0 = u.pn * BM + wc * 32 + 4 * fq;
        char* xb = (char*)(u.pm < 64 ? XL + (size_t)u.pm * BM * D : XCp + (size_t)(u.pm - 64) * BM * D);
        char* tb = (char*)(XT + (size_t)u.pm * BM * D);
        const unsigned off0 = (unsigned)((wr * 64 + fr) * D + col0);
        const float* gp = gate + set * MODS + col0; const float* sp = scn + set * MODS + col0; const float* np = nwn + col0;
        f32x4 ss0 = {0.f, 0.f, 0.f, 0.f}, ss1 = {0.f, 0.f, 0.f, 0.f};
#pragma unroll
        for (int bj = 0; bj < 2; ++bj)
#pragma unroll
            for (int n = 0; n < 2; ++n) { const int cc = bj * HALF + n * 16; const f32x4 g = *(const f32x4*)(gp + cc) * (0.5f * GS2);
                const f32x4 cw = *(const f32x4*)(np + cc) * (*(const f32x4*)(sp + cc) + 1.0f);
#pragma unroll
                for (int ai = 0; ai < 2; ++ai)
#pragma unroll
                    for (int m = 0; m < 4; ++m) { const unsigned off = off0 + (unsigned)((ai * HALF + m * 16) * D + cc);
                        f32x4* xp = (f32x4*)(xb + (size_t)off * 4u); const f32x4 xv = *xp + g * acc[ai][bj][m][n]; *xp = xv;
                        { const float q = (xv[0] * xv[0] + xv[1] * xv[1]) + (xv[2] * xv[2] + xv[3] * xv[3]); if (ai == 0) ss0[m] += q; else ss1[m] += q; }
                        { const f32x4 t = xv * cw; u32x2 w; w.x = cvt_pk_bf16(t[0], t[1]); w.y = cvt_pk_bf16(t[2], t[3]); *(u32x2*)(tb + (size_t)off * 2u) = w; } }
                asm volatile("" ::: "memory"); }
        float* sq = ssq + (size_t)(u.pm * BM + wr * 64 + fr) * 16 + u.pn * 4 + wc;
#pragma unroll
        for (int ai = 0; ai < 2; ++ai)
#pragma unroll
            for (int m = 0; m < 4; ++m) { float v = ai == 0 ? ss0[m] : ss1[m]; v += __shfl_xor(v, 16); v += __shfl_xor(v, 32); if (fq == 0) sq[(ai * HALF + m * 16) * 16] = v; }
    }
};
struct EpiWinF {
    static constexpr bool PERM = true, AFTER_DRAIN = false; static constexpr int MID_T = 0;
    bf16_t *Q, *K, *V, *ZB, *P, *SGA, *SGB; const float* rope; const float* ssq; const float* sw;
    __device__ __forceinline__ void mid(f32x4 (&)[2][2][4][2], const Unit&, int, int, int, int) const {}
    __device__ __forceinline__ void operator()(const f32x4 (&acc)[2][2][4][2], const Unit& u, int wr, int wc, int fr, int fq) const {
        const int set = tile_set(u.pm), row0 = u.pm * BM + wr * 64 + fr, jj0 = wc * 32 + 8 * fq, pn = u.pn;
        const float* swp = sw + set * SWN + pn * BM + jj0;
        f32x4 s0[2], s1[2];
#pragma unroll
        for (int n = 0; n < 2; ++n) { s0[n] = *(const f32x4*)(swp + 4 * n); s1[n] = *(const f32x4*)(swp + HALF + 4 * n); }
        const bool is_rope = pn < 2 || (pn == 2 && wc < 2);
#pragma unroll
        for (int ai = 0; ai < 2; ++ai)
#pragma unroll
            for (int m = 0; m < 4; ++m) { const int r = row0 + ai * HALF + m * 16; const float rs = rstd_row(ssq, r);
                f32x4 h0[2], h1[2];
#pragma unroll
                for (int n = 0; n < 2; ++n) { h0[n] = acc[ai][0][m][n] * rs + s0[n]; h1[n] = acc[ai][1][m][n] * rs + s1[n]; }
                if (is_rope) {
                    if (u.pm < 64) { const int t = r & (SEQ - 1), pos = fq < 2 ? (t >> 6) : (t & 63);
                        const f32x4* rp = (const f32x4*)(rope + (pos * 16 + 8 * (fq & 1)) * 2);
#pragma unroll
                        for (int n = 0; n < 2; ++n) { const f32x4 cs0 = rp[2 * n], cs1 = rp[2 * n + 1];
                            const f32x4 cc = (f32x4){cs0[0], cs0[2], cs1[0], cs1[2]}, sn = (f32x4){cs0[1], cs0[3], cs1[1], cs1[3]};
                            const f32x4 y1 = h0[n] * cc - h1[n] * sn, y2 = h1[n] * cc + h0[n] * sn; h0[n] = y1; h1[n] = y2; } }
                    const int d10 = fq < 2 ? 8 * fq : 16 + 8 * fq;
                    if (pn < 2) { bf16_t* dst = Q + (size_t)r * 512 + (pn * 4 + wc) * 64 + d10;
                        *(u32x4*)dst = pack8(h0[0] * QSCALE, h0[1] * QSCALE); *(u32x4*)(dst + 16) = pack8(h1[0] * QSCALE, h1[1] * QSCALE); }
                    else { bf16_t* dst = K + (size_t)r * 128 + wc * 64 + d10; *(u32x4*)dst = pack8(h0[0], h0[1]); *(u32x4*)(dst + 16) = pack8(h1[0], h1[1]); }
                } else if (pn == 2) { bf16_t* dst = V + (size_t)r * 128 + (wc - 2) * 32 + 8 * fq; *(u32x4*)dst = pack8(h0[0], h0[1]); *(u32x4*)(dst + 64) = pack8(h1[0], h1[1]); }
                else if (pn < 5) { bf16_t* dst = ZB + (size_t)r * 512 + (pn - 3) * BM + jj0; *(u32x4*)dst = pack8(h0[0], h0[1]); *(u32x4*)(dst + HALF) = pack8(h1[0], h1[1]); }
                else if (pn < 9) { bf16_t* dst = P + (size_t)r * 512 + (pn - 5) * HALF + jj0; *(u32x4*)dst = pack8(h0[0] * h1[0], h0[1] * h1[1]); }
                else { bf16_t* dst = (pn < 13 ? SGA + (size_t)r * D + (pn - 9) * BM : SGB + (size_t)r * D + (pn - 13) * BM) + jj0;
#pragma unroll
                    for (int n = 0; n < 2; ++n)
#pragma unroll
                        for (int e = 0; e < 4; ++e) { h0[n][e] = sigmoid_f(h0[n][e]); h1[n][e] = sigmoid_f(h1[n][e]); }
                    *(u32x4*)dst = pack8(h0[0], h0[1]); *(u32x4*)(dst + HALF) = pack8(h1[0], h1[1]); }
                if (m & 1) asm volatile("" ::: "memory"); }
    }
};
struct EpiMergeF {
    static constexpr bool PERM = true, AFTER_DRAIN = false; static constexpr int MID_T = 8;
    const bf16_t* SGA; const bf16_t* SGB; bf16_t* M;
    __device__ __forceinline__ void mid(f32x4 (&acc)[2][2][4][2], const Unit& u, int wr, int wc, int fr, int fq) const {
        const char* ga_b = (const char*)(SGA + (size_t)u.pm * BM * D); const char* gb_b = (const char*)(SGB + (size_t)u.pm * BM * D);
        const unsigned off0 = (unsigned)((wr * 64 + fr) * D + u.pn * BM + wc * 32 + 8 * fq) * 2u;
#pragma unroll
        for (int ai = 0; ai < 2; ++ai)
#pragma unroll
            for (int m = 0; m < 4; ++m) {
#pragma unroll
                for (int bj = 0; bj < 2; ++bj) { const unsigned off = off0 + (unsigned)((ai * HALF + m * 16) * D + bj * HALF) * 2u;
                    const u32x4 ga = *(const u32x4*)(ga_b + off), gb = *(const u32x4*)(gb_b + off);
                    f32x4 r0, r1;
                    r0[0] = bflo(ga.x) * fast_rcp(bflo(gb.x)); r0[1] = bfhi(ga.x) * fast_rcp(bfhi(gb.x)); r0[2] = bflo(ga.y) * fast_rcp(bflo(gb.y)); r0[3] = bfhi(ga.y) * fast_rcp(bfhi(gb.y));
                    r1[0] = bflo(ga.z) * fast_rcp(bflo(gb.z)); r1[1] = bfhi(ga.z) * fast_rcp(bfhi(gb.z)); r1[2] = bflo(ga.w) * fast_rcp(bflo(gb.w)); r1[3] = bfhi(ga.w) * fast_rcp(bfhi(gb.w));
                    acc[ai][bj][m][0] *= r0; acc[ai][bj][m][1] *= r1; }
                asm volatile("" ::: "memory"); }
    }
    __device__ __forceinline__ void operator()(const f32x4 (&acc)[2][2][4][2], const Unit& u, int wr, int wc, int fr, int fq) const {
        const char* gb_b = (const char*)(SGB + (size_t)u.pm * BM * D); char* m_b = (char*)(M + (size_t)u.pm * BM * D);
        const unsigned off0 = (unsigned)((wr * 64 + fr) * D + u.pn * BM + wc * 32 + 8 * fq) * 2u;
#pragma unroll
        for (int ai = 0; ai < 2; ++ai)
#pragma unroll
            for (int m = 0; m < 4; ++m) {
#pragma unroll
                for (int bj = 0; bj < 2; ++bj) { const unsigned off = off0 + (unsigned)((ai * HALF + m * 16) * D + bj * HALF) * 2u;
                    const u32x4 gb = *(const u32x4*)(gb_b + off);
                    const f32x4 g0 = (f32x4){bflo(gb.x), bfhi(gb.x), bflo(gb.y), bfhi(gb.y)}, g1 = (f32x4){bflo(gb.z), bfhi(gb.z), bflo(gb.w), bfhi(gb.w)};
                    *(u32x4*)(m_b + off) = pack8(acc[ai][bj][m][0] * g0, acc[ai][bj][m][1] * g1); }
                asm volatile("" ::: "memory"); }
    }
};

template <class Epi, class Sched, bool ALIGN_EPI = false, bool SP2 = false>
__device__ __forceinline__ void gemm_phase(PG8_LAS unsigned char* lds, const Gemm g, const Sched S, const Epi E) {
    int tid_o = threadIdx.x; asm volatile("" : "+v"(tid_o));
    const int tid = tid_o, wid = __builtin_amdgcn_readfirstlane(tid >> 6), lane = tid & 63, wr = wid >> 2, wc = wid & 3, fr = lane & 15, fq = lane >> 4;
    const int K = g.K, nt = K / BK;
    unsigned voffA[2], voffB[2];
#pragma unroll
    for (int i = 0; i < 2; ++i) { int R, C; stage_rc(tid * 16 + i * 8192, R, C); const int Rb = Epi::PERM ? ((R & ~31) + perm32(R & 31)) : R;
        voffA[i] = (unsigned)(R * K + C) * 2u; voffB[i] = (unsigned)(Rb * K + C) * 2u; }
    const size_t kstep = (size_t)(BK * 2);
    const size_t hstep = (size_t)HALF * K * 2;
    const size_t tstep = 2 * hstep;
    const unsigned ldsw = (unsigned)wid * 1024u;
    const int aoff = lds_byte(wr * 64 + fr, fq * 8), boff = lds_byte(wc * 32 + fr, fq * 8);
#define PG8_SA(b, h) (((b) * 2 + (h)) * HTB)
#define PG8_SB(b, h) ((4 + (b) * 2 + (h)) * HTB)
#define PG8_STAGE(bufoff, gbase, voff) do { _Pragma("unroll") for (int _i = 0; _i < 2; ++_i) \
        __builtin_amdgcn_global_load_lds((const unsigned*)((const char*)(gbase) + (voff)[_i]), (PG8_LAS unsigned*)(lds + (bufoff) + ldsw + _i * 8192), 16, 0, 0); } while (0)
#define PG8_LDA(dst, b, h) do { _Pragma("unroll") for (int m = 0; m < 4; ++m) _Pragma("unroll") for (int k = 0; k < 2; ++k) dst[m][k] = *(const PG8_LAS bf16x8*)(lds + PG8_SA(b, h) + aoff + m * 2048 + k * 1024); } while (0)
#define PG8_LDB(dst, b, h) do { _Pragma("unroll") for (int n = 0; n < 2; ++n) _Pragma("unroll") for (int k = 0; k < 2; ++k) dst[n][k] = *(const PG8_LAS bf16x8*)(lds + PG8_SB(b, h) + boff + n * 2048 + k * 1024); } while (0)
#define PG8_MMA(ai, bj, At, Bt) do { __builtin_amdgcn_s_setprio(1); _Pragma("unroll") for (int m = 0; m < 4; ++m) _Pragma("unroll") for (int n = 0; n < 2; ++n) _Pragma("unroll") for (int k = 0; k < 2; ++k) \
        acc[ai][bj][m][n] = __builtin_amdgcn_mfma_f32_16x16x32_bf16(Bt[n][k], At[m][k], acc[ai][bj][m][n], 0, 0, 0); __builtin_amdgcn_s_setprio(0); } while (0)
#define PG8_WAIT_V(n) asm volatile("s_waitcnt vmcnt(" #n ")" ::: "memory")
#define PG8_WAIT_L(n) asm volatile("s_waitcnt lgkmcnt(" #n ")" ::: "memory")
#define PG8_BAR __builtin_amdgcn_s_barrier()
#define PG8_SCHED __builtin_amdgcn_sched_barrier(0)
    Unit cur, nxt; int ui = 0;
    if (!S.next(0, cur)) return;
    f32x4 acc[2][2][4][2];
#pragma unroll
    for (int a = 0; a < 2; ++a)
#pragma unroll
        for (int b = 0; b < 2; ++b)
#pragma unroll
            for (int m = 0; m < 4; ++m)
#pragma unroll
                for (int n = 0; n < 2; ++n) acc[a][b][m][n] = (f32x4){0.f, 0.f, 0.f, 0.f};
    bf16x8 At[4][2], B0[2][2], B1[2][2];
    const char* cA = (const char*)g.A + (size_t)cur.pm * tstep; const char* cB = (const char*)g.Bt + (size_t)cur.pn * tstep;
    S.a_ready(cur);
    if constexpr (SP2) {
        PG8_STAGE(PG8_SB(0, 0), cB, voffB); PG8_STAGE(PG8_SB(0, 1), cB + hstep, voffB); PG8_STAGE(PG8_SA(0, 0), cA, voffA); PG8_STAGE(PG8_SA(0, 1), cA + hstep, voffA);
        if (wr == 1) PG8_BAR;
        PG8_WAIT_V(2); PG8_BAR;
        PG8_STAGE(PG8_SB(1, 0), cB + kstep, voffB); PG8_STAGE(PG8_SA(1, 0), cA + kstep, voffA); PG8_STAGE(PG8_SB(1, 1), cB + hstep + kstep, voffB);
        PG8_WAIT_V(6); PG8_BAR;
    } else {
        PG8_STAGE(PG8_SB(0, 0), cB, voffB); PG8_STAGE(PG8_SA(0, 0), cA, voffA); PG8_STAGE(PG8_SB(0, 1), cB + hstep, voffB); PG8_STAGE(PG8_SA(0, 1), cA + hstep, voffA);
        if (wr == 1) PG8_BAR;
        PG8_WAIT_V(4); PG8_BAR;
        PG8_STAGE(PG8_SB(1, 0), cB + kstep, voffB); PG8_STAGE(PG8_SA(1, 0), cA + kstep, voffA); PG8_STAGE(PG8_SB(1, 1), cB + hstep + kstep, voffB);
        PG8_WAIT_V(6); PG8_BAR;
    }
    for (;;) {
        const bool has_next = S.next(ui + 1, nxt);
        const char* nA = has_next ? (const char*)g.A + (size_t)nxt.pm * tstep : cA; const char* nB = has_next ? (const char*)g.Bt + (size_t)nxt.pn * tstep : cB;
        constexpr int NSEG = Epi::MID_T > 0 ? 2 : 1;
#pragma unroll
        for (int sg = 0; sg < NSEG; ++sg) {
        const int t_lo = sg == 0 ? 0 : Epi::MID_T, t_hi = (NSEG == 2 && sg == 0) ? Epi::MID_T : nt;
        if constexpr (NSEG == 2) { if (sg == 1) { int fr_e = fr, fq_e = fq; asm volatile("" : "+v"(fr_e), "+v"(fq_e)); E.mid(acc, cur, wr, wc, fr_e, fq_e); } }
        for (int t = t_lo; t < t_hi; t += 2) {
            const bool last = (t == nt - 2);
            const char* a1 = cA + (size_t)(t + 1) * kstep;
            const char* a2 = last ? nA : cA + (size_t)(t + 2) * kstep; const char* b2 = last ? nB : cB + (size_t)(t + 2) * kstep;
            const char* a3 = a2 + kstep; const char* b3 = b2 + kstep;
            if (last && has_next) S.a_ready(nxt);
            if constexpr (SP2) {
            PG8_LDB(B0, 0, 0); PG8_LDB(B1, 0, 1); PG8_SCHED; PG8_LDA(At, 0, 0); PG8_STAGE(PG8_SA(1, 1), a1 + hstep, voffA);
            PG8_WAIT_V(8); PG8_WAIT_L(0); PG8_BAR; PG8_MMA(0, 0, At, B0); PG8_MMA(0, 1, At, B1); PG8_BAR; PG8_SCHED;
            PG8_LDA(At, 0, 1); PG8_STAGE(PG8_SB(0, 0), b2, voffB); PG8_STAGE(PG8_SB(0, 1), b2 + hstep, voffB); PG8_STAGE(PG8_SA(0, 0), a2, voffA);
            PG8_WAIT_V(8); PG8_WAIT_L(0); PG8_BAR; PG8_MMA(1, 0, At, B0); PG8_MMA(1, 1, At, B1); PG8_BAR; PG8_SCHED;
            PG8_LDB(B0, 1, 0); PG8_LDB(B1, 1, 1); PG8_SCHED; PG8_LDA(At, 1, 0); PG8_STAGE(PG8_SA(0, 1), a2 + hstep, voffA);
            PG8_WAIT_V(8); PG8_WAIT_L(0); PG8_BAR; PG8_MMA(0, 0, At, B0); PG8_MMA(0, 1, At, B1); PG8_BAR; PG8_SCHED;
            PG8_LDA(At, 1, 1); PG8_STAGE(PG8_SB(1, 0), b3, voffB); PG8_STAGE(PG8_SB(1, 1), b3 + hstep, voffB); PG8_STAGE(PG8_SA(1, 0), a3, voffA);
            PG8_WAIT_V(8); PG8_WAIT_L(0); PG8_BAR; PG8_MMA(1, 0, At, B0); PG8_MMA(1, 1, At, B1); PG8_BAR; PG8_SCHED;
            } else {
            PG8_LDB(B0, 0, 0); PG8_SCHED; PG8_LDA(At, 0, 0); PG8_STAGE(PG8_SA(1, 1), a1 + hstep, voffA);
            PG8_WAIT_L(8); PG8_BAR; PG8_WAIT_L(0); PG8_MMA(0, 0, At, B0); PG8_BAR; PG8_SCHED;
            PG8_LDB(B1, 0, 1); PG8_STAGE(PG8_SB(0, 0), b2, voffB);
            PG8_BAR; PG8_WAIT_L(0); PG8_MMA(0, 1, At, B1); PG8_BAR;
            PG8_LDA(At, 0, 1); PG8_STAGE(PG8_SA(0, 0), a2, voffA);
            PG8_BAR; PG8_WAIT_L(0); PG8_MMA(1, 0, At, B0); PG8_BAR; PG8_SCHED;
            PG8_STAGE(PG8_SB(0, 1), b2 + hstep, voffB);
            PG8_WAIT_V(6); PG8_BAR; PG8_MMA(1, 1, At, B1); PG8_BAR;
            PG8_LDB(B0, 1, 0); PG8_SCHED; PG8_LDA(At, 1, 0); PG8_STAGE(PG8_SA(0, 1), a2 + hstep, voffA);
            PG8_WAIT_L(8); PG8_BAR; PG8_WAIT_L(0); PG8_MMA(0, 0, At, B0); PG8_BAR; PG8_SCHED;
            PG8_LDB(B1, 1, 1); PG8_STAGE(PG8_SB(1, 0), b3, voffB);
            PG8_BAR; PG8_WAIT_L(0); PG8_MMA(0, 1, At, B1); PG8_BAR;
            PG8_LDA(At, 1, 1); PG8_STAGE(PG8_SA(1, 0), a3, voffA);
            PG8_BAR; PG8_WAIT_L(0); PG8_MMA(1, 0, At, B0); PG8_BAR; PG8_SCHED;
            PG8_STAGE(PG8_SB(1, 1), b3 + hstep, voffB);
            PG8_WAIT_V(6); PG8_BAR; PG8_MMA(1, 1, At, B1); PG8_BAR;
            }
        }
        }
        if constexpr (ALIGN_EPI) { if (wr == 0) PG8_BAR; }
        if constexpr (!Epi::AFTER_DRAIN) { int fr_e = fr, fq_e = fq; asm volatile("" : "+v"(fr_e), "+v"(fq_e)); E(acc, cur, wr, wc, fr_e, fq_e); S.done(cur); }
        if (!has_next) break;
#pragma unroll
        for (int a = 0; a < 2; ++a)
#pragma unroll
            for (int b = 0; b < 2; ++b)
#pragma unroll
                for (int m = 0; m < 4; ++m)
#pragma unroll
                    for (int n = 0; n < 2; ++n) acc[a][b][m][n] = (f32x4){0.f, 0.f, 0.f, 0.f};
        cur = nxt; cA = nA; cB = nB; ++ui;
        if constexpr (ALIGN_EPI) { if (wr == 1) PG8_BAR; }
    }
    PG8_WAIT_V(0);
    if constexpr (!ALIGN_EPI) { if (wr == 0) PG8_BAR; }
    PG8_BAR;
    if constexpr (Epi::AFTER_DRAIN) { E.fused(acc, cur, wr, wc, fr, fq, lds, wid, lane); S.done(cur); }
#undef PG8_SA
#undef PG8_SB
#undef PG8_STAGE
#undef PG8_LDA
#undef PG8_LDB
#undef PG8_MMA
#undef PG8_WAIT_V
#undef PG8_WAIT_L
#undef PG8_BAR
#undef PG8_SCHED
}

}

#define XB_TMO      128
#define XB_XCNT(j)  (256  + 64 * (j))
#define XB_XSUB(j)  (1280 + 64 * (j))
#define XB_XGEN(j)  (2304 + 64 * (j))
#define XB_TOP      3328
#define XB_TOPGEN   3392
#define XCD_BAR_WORDS 3456
#define XB_SPIN_CAP (1u << 18)

__device__ __forceinline__ unsigned xb_ld(unsigned* p)              { return __hip_atomic_load(p, __ATOMIC_RELAXED, __HIP_MEMORY_SCOPE_AGENT); }
__device__ __forceinline__ unsigned xb_add(unsigned* p, unsigned v) { return __hip_atomic_fetch_add(p, v, __ATOMIC_RELAXED, __HIP_MEMORY_SCOPE_AGENT); }
__device__ __forceinline__ unsigned xb_xcc_id() { return (unsigned)__builtin_amdgcn_s_getreg((3 << 11) | 20) & 0xFu; }
#define XB_SPIN(cond, bar) do { unsigned _sp = 0; while (cond) { __builtin_amdgcn_s_sleep(1); \
    if ((++_sp & 255u) == 0u) { if (xb_ld(&(bar)[XB_TMO])) break; if (_sp > XB_SPIN_CAP) { atomicAdd(&(bar)[XB_TMO], 1u); break; } } } } while (0)

struct XcdBarrier {
    unsigned* bar; unsigned x;
    volatile LAS unsigned* st;
};

__device__ __forceinline__ XcdBarrier xcd_barrier_post(unsigned* bar, volatile LAS unsigned* st) {
    XcdBarrier b; b.bar = bar; b.x = xb_xcc_id(); b.st = st;
    if (threadIdx.x == 0) (void)xb_add(&bar[XB_XCNT(b.x)], 1u);
    return b;
}
__device__ __forceinline__ void xcd_barrier_complete(unsigned* bar, unsigned x, unsigned& nloc, unsigned& nx) {
    const unsigned G = gridDim.x * gridDim.y * gridDim.z;
    unsigned sum, cnt, mine, sp = 0u;
    for (;;) {
        sum = 0u; cnt = 0u; mine = 0u;
#pragma unroll
        for (unsigned j = 0; j < 16; ++j) { const unsigned c = xb_ld(&bar[XB_XCNT(j)]); sum += c; cnt += (c > 0u) ? 1u : 0u; mine = (j == x) ? c : mine; }
        if (sum == G) break;
        __builtin_amdgcn_s_sleep(1);
        if ((++sp & 255u) == 0u) { if (xb_ld(&bar[XB_TMO])) break; if (sp > XB_SPIN_CAP) { atomicAdd(&bar[XB_TMO], 1u); break; } }
    }
    nloc = mine > 0u ? mine : 1u; nx = cnt > 0u ? cnt : 1u;
}

__device__ __forceinline__ void xcd_barrier(const XcdBarrier& b) {
    asm volatile("s_waitcnt vmcnt(0)" ::: "memory");
    __syncthreads();
    if (threadIdx.x == 0) {
        unsigned long long bar_o = (unsigned long long)b.bar; unsigned bx_o = b.x; asm volatile("" : "+s"(bar_o), "+s"(bx_o));
        unsigned* bar = (unsigned*)bar_o; XcdBarrier bb; bb.bar = bar; bb.x = bx_o; bb.st = b.st; const XcdBarrier& b = bb;
        __builtin_amdgcn_s_waitcnt(0);
        unsigned nloc = b.st[0], nx = b.st[1];
        if (nloc == 0u) { xcd_barrier_complete(bar, b.x, nloc, nx); b.st[0] = nloc; b.st[1] = nx; }
        const unsigned old = xb_add(&bar[XB_XSUB(b.x)], 1u);
        const unsigned gen = old / nloc;
        if (old + 1u == (gen + 1u) * nloc) {
            __builtin_amdgcn_fence(__ATOMIC_RELEASE, "agent");
            asm volatile("s_waitcnt vmcnt(0)" ::: "memory");
            const unsigned og = xb_add(&bar[XB_TOP], 1u);
            const unsigned tg = og / nx;
            if (og + 1u == (tg + 1u) * nx) xb_add(&bar[XB_TOPGEN], 1u);
            else XB_SPIN(xb_ld(&bar[XB_TOPGEN]) == tg, bar);
            __builtin_amdgcn_fence(__ATOMIC_ACQUIRE, "agent");
            xb_add(&bar[XB_XGEN(b.x)], 1u);
            asm volatile("s_waitcnt vmcnt(0)" ::: "memory");
        } else {
            XB_SPIN(xb_ld(&bar[XB_XGEN(b.x)]) == gen, bar);
            __builtin_amdgcn_fence(__ATOMIC_ACQUIRE, "agent");
            asm volatile("s_waitcnt vmcnt(0)" ::: "memory");
        }
    }
    __syncthreads();
}


typedef float f32x4 __attribute__((ext_vector_type(4)));
typedef unsigned u32x4 __attribute__((ext_vector_type(4)));
#define LDS_WAIT() asm volatile("s_waitcnt lgkmcnt(0)" ::: "memory")

struct Args { const float* in[18]; float* out; unsigned char* ws; };

__device__ __forceinline__ void p0a_mod(const float* c, const float* c_ctx, const float* w_ada, const float* b_ada, float* mod, LAS float* scr, int gw, int ngw, int lane) {
    for (int it = gw; it < DEPTH * 36 * 16; it += ngw) {
        const int ks = it & 15, cb = (it >> 4) % 36, l = it / 576, k = ks * 64 + lane;
        { const float v0 = c[k], v1 = c[D + k], v2 = c_ctx[k]; scr[lane] = v0 * sigmoid_f(v0); scr[64 + lane] = v1 * sigmoid_f(v1); scr[128 + lane] = v2 * sigmoid_f(v2); }
        LDS_WAIT();
        const float* w = w_ada + ((size_t)l * D + ks * 64) * MODS + cb * 256 + lane * 4;
        f32x4 a0 = {0.f, 0.f, 0.f, 0.f}, a1 = a0, a2 = a0;
#pragma unroll 8
        for (int kk = 0; kk < 64; ++kk) { const f32x4 wv = *(const f32x4*)(w + (size_t)kk * MODS); a0 += wv * scr[kk]; a1 += wv * scr[64 + kk]; a2 += wv * scr[128 + kk]; }
        if (ks == 0) { const f32x4 bb = *(const f32x4*)(b_ada + l * MODS + cb * 256 + lane * 4); a0 += bb; a1 += bb; a2 += bb; }
        float* m0 = mod + (size_t)(l * 3) * MODS + cb * 256 + lane * 4;
#pragma unroll
        for (int e = 0; e < 4; ++e) { __hip_atomic_fetch_add(m0 + e, a0[e], __ATOMIC_RELAXED, __HIP_MEMORY_SCOPE_AGENT); __hip_atomic_fetch_add(m0 + MODS + e, a1[e], __ATOMIC_RELAXED, __HIP_MEMORY_SCOPE_AGENT);
                                      __hip_atomic_fetch_add(m0 + 2 * MODS + e, a2[e], __ATOMIC_RELAXED, __HIP_MEMORY_SCOPE_AGENT); }
        LDS_WAIT();
    }
}
__device__ __forceinline__ void p0a_rope(float* rope, int tid) {
    for (int i = tid; i < 128 * 16; i += NWAVES * 64) {
        const int pos = i >> 4, f = i & 15;
        const float inv = exp2f(-(float)f * (13.287712379549449f / 16.0f));
        const float ang = (float)pos * inv;
        const double rev = (double)ang * 0.15915494309189535; const float fr = (float)(rev - floor(rev));
        rope[2 * i] = __builtin_amdgcn_cosf(fr); rope[2 * i + 1] = __builtin_amdgcn_sinf(fr);
    }
}
__device__ __forceinline__ void p0_transpose_item(const float* W, int K, int N, int Nd, bf16* dst, int ldk, int koff, int map, LAS float* scr, int item, int lane) {
    const int nblk = Nd / 32, kb = item / nblk, nb = item % nblk, k0 = 64 * kb, n0 = 32 * nb;
    const int sc = src_col(map, n0 + (lane & 31));
#pragma unroll 8
    for (int i = 0; i < 32; ++i) { const int kk = 2 * i + (lane >> 5); scr[kk * 33 + (lane & 31)] = W[(size_t)(k0 + kk) * N + sc]; }
    LDS_WAIT(); asm volatile("" ::: "memory");
    const int c = lane & 7;
#pragma unroll
    for (int j = 0; j < 4; ++j) { const int n = (lane >> 3) + 8 * j; const LAS float* s = scr + (8 * c) * 33 + n;
        u32x4 o; o.x = pk2(s[0 * 33], s[1 * 33]); o.y = pk2(s[2 * 33], s[3 * 33]); o.z = pk2(s[4 * 33], s[5 * 33]); o.w = pk2(s[6 * 33], s[7 * 33]);
        *(u32x4*)(dst + (size_t)(n0 + n) * ldk + koff + k0 + 8 * c) = o; }
    LDS_WAIT(); asm volatile("" ::: "memory");
}
constexpr int CI_WI = (D / 64) * (2 * DFF / 32), CI_WO = (DFF / 64) * (D / 32), CI_WIN = (D / 64) * (PROJ_W / 32), CI_WAB = (512 / 64) * (D / 32), CI_WOUT = (D / 64) * (D / 32);
constexpr int CI_LAYER = 2 * CI_WI + 2 * CI_WO + CI_WIN + 2 * CI_WAB + CI_WOUT;
__device__ __forceinline__ void p0a_convert(const __attribute__((address_space(4))) Args* ap, LAS float* scr, int gw, int ngw, int lane) {
    const __attribute__((address_space(4))) Args& a = *ap;
    for (int it = gw; it < DEPTH * CI_LAYER; it += ngw) {
        const int l = it / CI_LAYER; int r = it % CI_LAYER; unsigned char* wl = a.ws + WS_W + (size_t)l * W_LAYER;
        if (r < CI_WI) { p0_transpose_item(a.in[7] + (size_t)l * D * 2 * DFF, D, 2 * DFF, 2 * DFF, (bf16*)(wl + W_WI1), D, 0, 1, scr, r, lane); continue; } r -= CI_WI;
        if (r < CI_WO) { p0_transpose_item(a.in[8] + (size_t)l * DFF * D, DFF, D, D, (bf16*)(wl + W_WO1), DFF, 0, 0, scr, r, lane); continue; } r -= CI_WO;
        if (r < CI_WIN) { p0_transpose_item(a.in[9] + (size_t)l * D * PROJ_W, D, PROJ_W, PROJ_W, (bf16*)(wl + W_WIN), D, 0, 2, scr, r, lane); continue; } r -= CI_WIN;
        if (r < CI_WAB) { p0_transpose_item(a.in[12] + (size_t)l * 512 * D, 512, D, D, (bf16*)(wl + W_WM), D, 0, 0, scr, r, lane); continue; } r -= CI_WAB;
        if (r < CI_WAB) { p0_transpose_item(a.in[13] + (size_t)l * 512 * D, 512, D, D, (bf16*)(wl + W_WM), D, 512, 0, scr, r, lane); continue; } r -= CI_WAB;
        if (r < CI_WOUT) { p0_transpose_item(a.in[14] + (size_t)l * D * D, D, D, D, (bf16*)(wl + W_WOUT), D, 0, 0, scr, r, lane); continue; } r -= CI_WOUT;
        if (r < CI_WI) { p0_transpose_item(a.in[15] + (size_t)l * D * 2 * DFF, D, 2 * DFF, 2 * DFF, (bf16*)(wl + W_WI2), D, 0, 1, scr, r, lane); continue; } r -= CI_WI;
        p0_transpose_item(a.in[16] + (size_t)l * DFF * D, DFF, D, D, (bf16*)(wl + W_WO2), DFF, 0, 0, scr, r, lane);
    }
}
__device__ __forceinline__ void p0b_rows(const float* x, const float* ctx, float* XL, float* XCp, const float* nw, const float* mod0  , bf16* XT, float* ssq, int gw, int ngw, int lane) {
    for (int r = gw; r < R; r += ngw) {
        const float* src = r < ML ? x + (size_t)r * D : ctx + (size_t)(r - ML) * D; float* dst = r < ML ? XL + (size_t)r * D : XCp + (size_t)(r - ML) * D;
        const int set = r < SEQ ? 0 : (r < ML ? 1 : 2); const float* scl = mod0 + set * MODS + 1 * D;
        float ss = 0.f;
#pragma unroll
        for (int j = 0; j < 4; ++j) { const int k = 256 * j + 4 * lane; const f32x4 v = *(const f32x4*)(src + k); *(f32x4*)(dst + k) = v; ss += (v[0] * v[0] + v[1] * v[1]) + (v[2] * v[2] + v[3] * v[3]);
            const f32x4 t = v * (*(const f32x4*)(nw + k)) * (*(const f32x4*)(scl + k) + 1.0f); u32x2 w; w.x = pk2(t[0], t[1]); w.y = pk2(t[2], t[3]); *(u32x2*)(XT + (size_t)r * D + k) = w; }
        ss = wave_sum(ss);
        if (lane < 16) ssq[(size_t)r * 16 + lane] = lane == 0 ? ss : 0.f;
    }
}
__device__ __forceinline__ void p0b_sw(const unsigned char* ws, const float* mod, float* sw, int gw, int ngw, int lane) {
    constexpr int NR = 2 * DFF + PROJ_W + 2 * DFF;
    for (int it = gw; it < DEPTH * NR; it += ngw) {
        const int l = it / NR; int n = it % NR; int s, ish; const unsigned char* wl = ws + WS_W + (size_t)l * W_LAYER; const bf16* bt;
        if (n < 2 * DFF) { s = 0; ish = 0; bt = (const bf16*)(wl + W_WI1); } else if (n < 2 * DFF + PROJ_W) { n -= 2 * DFF; s = 1; ish = 3; bt = (const bf16*)(wl + W_WIN); } else { n -= 2 * DFF + PROJ_W; s = 2; ish = 6; bt = (const bf16*)(wl + W_WI2); }
        const u32x4 w0 = *(const u32x4*)(bt + (size_t)n * D + 8 * lane), w1 = *(const u32x4*)(bt + (size_t)n * D + 512 + 8 * lane);
        float wv[16] = {bflo(w0.x), bfhi(w0.x), bflo(w0.y), bfhi(w0.y), bflo(w0.z), bfhi(w0.z), bflo(w0.w), bfhi(w0.w), bflo(w1.x), bfhi(w1.x), bflo(w1.y), bfhi(w1.y), bflo(w1.z), bfhi(w1.z), bflo(w1.w), bfhi(w1.w)};
#pragma unroll
        for (int set = 0; set < 3; ++set) { const float* sh = mod + (size_t)(l * 3 + set) * MODS + ish * D; float acc = 0.f;
#pragma unroll
            for (int h = 0; h < 2; ++h) { const f32x4 a = *(const f32x4*)(sh + 512 * h + 8 * lane), b = *(const f32x4*)(sh + 512 * h + 8 * lane + 4);
                acc += a[0] * wv[8 * h] + a[1] * wv[8 * h + 1] + a[2] * wv[8 * h + 2] + a[3] * wv[8 * h + 3] + b[0] * wv[8 * h + 4] + b[1] * wv[8 * h + 5] + b[2] * wv[8 * h + 6] + b[3] * wv[8 * h + 7]; }
            acc = wave_sum(acc);
            if (lane == 0) sw[(size_t)((l * 3 + s) * 3 + set) * SWN + n] = acc; }
    }
}
typedef float f32x16 __attribute__((ext_vector_type(16)));
typedef short s16x8 __attribute__((ext_vector_type(8)));
typedef short s16x4 __attribute__((ext_vector_type(4)));
constexpr int AT_KP = 144, AT_VP = 264, AT_KB = 128 * AT_KP, AT_VB = 64 * AT_VP, AT_BUF = AT_KB + AT_VB;
static_assert(2 * AT_BUF <= RING_BYTES, "attention buffers fit the ring region");
__device__ __forceinline__ void attn_stage_load(u32x4 (&kr)[2], u32x4 (&vr)[2], const bf16* K, const bf16* V, int rowstart, int kh, int tid) {
#pragma unroll
    for (int j = 0; j < 2; ++j) { const int p = tid + 512 * j, row = p >> 3, pc = p & 7; const size_t off = (size_t)(rowstart + row) * 128 + kh * 64 + pc * 8;
        kr[j] = *(const u32x4*)(K + off); vr[j] = *(const u32x4*)(V + off); }
}
__device__ __forceinline__ void attn_stage_write(LAS unsigned char* buf, const u32x4 (&kr)[2], const u32x4 (&vr)[2], int tid) {
#pragma unroll
    for (int j = 0; j < 2; ++j) { const int p = tid + 512 * j, row = p >> 3, pc = p & 7;
        *(LAS u32x4*)(buf + row * AT_KP + pc * 16) = kr[j];
        LAS unsigned short* vt = (LAS unsigned short*)(buf + AT_KB) + (pc * 8) * (AT_VP / 2) + row;
#pragma unroll
        for (int e = 0; e < 4; ++e) { vt[(2 * e) * (AT_VP / 2)] = (unsigned short)(vr[j][e] & 0xffffu); vt[(2 * e + 1) * (AT_VP / 2)] = (unsigned short)(vr[j][e] >> 16); } }
}
__device__ __forceinline__ void attn_unit(LAS unsigned char* lds, const bf16* Q, const bf16* K, const bf16* V, const float* sink, bf16* OY, int qrow0, int b, int n, int kh, bool ctxu, int tid) {
    const int lane = tid & 63, w = __builtin_amdgcn_readfirstlane(tid >> 6), g = w & 3, th = w >> 2, h = kh * 4 + g, l31 = lane & 31, hf = lane >> 5;
    const bool has_prev = !ctxu && n > 0, has_next = !ctxu && n < 63; const int nch = ctxu ? 2 : 3 + (has_prev ? 1 : 0) + (has_next ? 1 : 0);
    s16x8 qf[2][4];
    { const bf16* qp = Q + (size_t)(qrow0 + 64 * th + l31) * 512 + h * 64 + 8 * hf;
#pragma unroll
      for (int qb = 0; qb < 2; ++qb)
#pragma unroll
          for (int s = 0; s < 4; ++s) qf[qb][s] = *(const s16x8*)(qp + (size_t)qb * 32 * 512 + 16 * s); }
    f32x16 o[2][2];
#pragma unroll
    for (int qb = 0; qb < 2; ++qb)
#pragma unroll
        for (int db = 0; db < 2; ++db)
#pragma unroll
            for (int r = 0; r < 16; ++r) o[qb][db][r] = 0.f;
    float mrun[2] = {-1.0e30f, -1.0e30f}, lrun[2] = {0.f, 0.f};
    u32x4 kr[2], vr[2];
    attn_stage_load(kr, vr, K, V, ML + b * CTX, kh, tid);
    attn_stage_write(lds, kr, vr, tid);
    __syncthreads();
#pragma unroll 1
    for (int i = 0; i < nch; ++i) {
        const int c = i < 2 ? i : (has_prev ? i : i + 1), kind = c == 2 ? 1 : (c == 4 ? 2 : 0);
        if (i + 1 < nch) { const int c1 = (i + 1) < 2 ? i + 1 : (has_prev ? i + 1 : i + 2); const int rs1 = c1 < 2 ? ML + b * CTX + c1 * 128 : b * SEQ + (n + c1 - 3) * 128; attn_stage_load(kr, vr, K, V, rs1, kh, tid); }
        LAS unsigned char* buf = lds + (i & 1) * AT_BUF;
#pragma unroll 1
        for (int kt = 0; kt < 4; ++kt) {
            if (kind == 1 && kt * 32 + 31 < 64 * th) continue;
            if (kind == 2 && kt * 32 > 64 * th + 63) continue;
            s16x8 kf[4], vf[2][2];
            { const LAS unsigned char* kp = buf + (kt * 32 + l31) * AT_KP + 16 * hf;
#pragma unroll
              for (int s = 0; s < 4; ++s) kf[s] = *(const LAS s16x8*)(kp + 32 * s); }
            { const LAS unsigned char* vp = buf + AT_KB + l31 * AT_VP + (kt * 32 + 4 * hf) * 2;
#pragma unroll
              for (int db = 0; db < 2; ++db)
#pragma unroll
                  for (int s = 0; s < 2; ++s) { const s16x4 lo = *(const LAS s16x4*)(vp + db * 32 * AT_VP + 32 * s), hi = *(const LAS s16x4*)(vp + db * 32 * AT_VP + 32 * s + 16);
                      vf[db][s] = (s16x8){lo[0], lo[1], lo[2], lo[3], hi[0], hi[1], hi[2], hi[3]}; } }
#pragma unroll
            for (int qb = 0; qb < 2; ++qb) {
                f32x16 sc;
#pragma unroll
                for (int r = 0; r < 16; ++r) sc[r] = 0.f;
#pragma unroll
                for (int s = 0; s < 4; ++s) sc = __builtin_amdgcn_mfma_f32_32x32x16_bf16(kf[s], qf[qb][s], sc, 0, 0, 0);
                if (kind != 0) { const int dq = 64 * th + 32 * qb + l31 - kt * 32 - 4 * hf;
#pragma unroll
                    for (int r = 0; r < 16; ++r) { const int krr = (r & 3) + 8 * (r >> 2); const bool ok = kind == 1 ? (krr >= dq) : (krr <= dq); sc[r] = ok ? sc[r] : -1.0e30f; } }
                float tmax = sc[0];
#pragma unroll
                for (int r = 1; r < 16; ++r) tmax = fmaxf(tmax, sc[r]);
                tmax = fmaxf(tmax, __shfl_xor(tmax, 32));
                const float mnew = fmaxf(mrun[qb], tmax), alpha = fast_exp2(mrun[qb] - mnew); mrun[qb] = mnew;
                float psum = 0.f;
#pragma unroll
                for (int r = 0; r < 16; ++r) { sc[r] = fast_exp2(sc[r] - mnew); psum += sc[r]; }
                lrun[qb] = lrun[qb] * alpha + psum;
#pragma unroll
                for (int db = 0; db < 2; ++db)
#pragma unroll
                    for (int r = 0; r < 16; ++r) o[qb][db][r] *= alpha;
                u32x4 pw[2];
#pragma unroll
                for (int s = 0; s < 2; ++s) { pw[s].x = pg8::cvt_pk_bf16(sc[8 * s], sc[8 * s + 1]); pw[s].y = pg8::cvt_pk_bf16(sc[8 * s + 2], sc[8 * s + 3]); pw[s].z = pg8::cvt_pk_bf16(sc[8 * s + 4], sc[8 * s + 5]); pw[s].w = pg8::cvt_pk_bf16(sc[8 * s + 6], sc[8 * s + 7]); }
#pragma unroll
                for (int db = 0; db < 2; ++db)
#pragma unroll
                    for (int s = 0; s < 2; ++s) o[qb][db] = __builtin_amdgcn_mfma_f32_32x32x16_bf16(vf[db][s], __builtin_bit_cast(s16x8, pw[s]), o[qb][db], 0, 0, 0);
            }
        }
        if (i + 1 < nch) attn_stage_write(lds + ((i + 1) & 1) * AT_BUF, kr, vr, tid);
        __syncthreads();
    }
    const float sk = sink[h] * LOG2E;
#pragma unroll
    for (int qb = 0; qb < 2; ++qb) {
        float lt = lrun[qb] + __shfl_xor(lrun[qb], 32); lt += fast_exp2(sk - mrun[qb]); const float inv = 1.0f / lt;
        bf16* rowp = OY + (size_t)(qrow0 + 64 * th + 32 * qb + l31) * D + h * 64 + 4 * hf;
#pragma unroll
        for (int db = 0; db < 2; ++db)
#pragma unroll
            for (int g4 = 0; g4 < 4; ++g4) { u32x2 wv; wv.x = pg8::cvt_pk_bf16(o[qb][db][4 * g4] * inv, o[qb][db][4 * g4 + 1] * inv); wv.y = pg8::cvt_pk_bf16(o[qb][db][4 * g4 + 2] * inv, o[qb][db][4 * g4 + 3] * inv);
                *(u32x2*)(rowp + db * 32 + 8 * g4) = wv; }
    }
}
__device__ __forceinline__ void attn_phase(LAS unsigned char* lds, const bf16* Q, const bf16* K, const bf16* V, const float* sink, bf16* OY, bool with_ctx, int G, int bx, int tid) {
    for (int u = bx; u < 256; u += G) {
        const int kh = u & 1, n = (u >> 1) & 63, b = u >> 7;
        attn_unit(lds, Q, K, V, sink, OY, b * SEQ + n * 128, b, n, kh, false, tid);
        if (with_ctx && (n == 0 || n == 63)) attn_unit(lds, Q, K, V, sink, OY, ML + b * CTX + (n == 63 ? 128 : 0), b, 0, kh, true, tid);
    }
}
__device__ __forceinline__ void conv_phase(const bf16* ZB, const bf16* P, const float* cw, bf16* OY, int nrows, int gt, int ngt) {
    for (int g = gt; g < nrows * 64; g += ngt) {
        const int r = g >> 6, j = (g & 63) * 8;
        bool first, last; if (r < ML) { const int t = r & (SEQ - 1); first = t == 0; last = t == SEQ - 1; } else { const int l = (r - ML) & (CTX - 1); first = l == 0; last = l == CTX - 1; }
        const u32x4 z = *(const u32x4*)(ZB + (size_t)r * 512 + j), p0 = *(const u32x4*)(P + (size_t)r * 512 + j);
        u32x4 pm = {0u, 0u, 0u, 0u}, pp = {0u, 0u, 0u, 0u};
        if (!first) pm = *(const u32x4*)(P + (size_t)(r - 1) * 512 + j);
        if (!last) pp = *(const u32x4*)(P + (size_t)(r + 1) * 512 + j);
        const f32x4 w0a = *(const f32x4*)(cw + j), w0b = *(const f32x4*)(cw + j + 4), w1a = *(const f32x4*)(cw + 512 + j), w1b = *(const f32x4*)(cw + 512 + j + 4), w2a = *(const f32x4*)(cw + 1024 + j), w2b = *(const f32x4*)(cw + 1024 + j + 4);
        u32x4 o;
#define CONV2(W, I0, WA, I1) o.W = pk2(bflo(z.W) * (WA##0[I0] * bflo(pm.W) + WA##1[I0] * bflo(p0.W) + WA##2[I0] * bflo(pp.W)), bfhi(z.W) * (WA##0[I1] * bfhi(pm.W) + WA##1[I1] * bfhi(p0.W) + WA##2[I1] * bfhi(pp.W)))
        { const f32x4 A0 = w0a, A1 = w1a, A2 = w2a, B0 = w0b, B1 = w1b, B2 = w2b;
          CONV2(x, 0, A, 1); CONV2(y, 2, A, 3); CONV2(z, 0, B, 1); CONV2(w, 2, B, 3); }
#undef CONV2
        *(u32x4*)(OY + (size_t)r * D + 512 + j) = o;
    }
}
__device__ __forceinline__ void final_phase(float* XL, const float* ssq, const float* fw, int gw, int ngw, int lane) {
    for (int r = gw; r < ML; r += ngw) {
        float s = lane < 16 ? ssq[(size_t)r * 16 + lane] : 0.f; s = wave_sum(s);
        const float rstd = rsqrtf(s * (1.0f / D) + EPS); float* x = XL + (size_t)r * D;
#pragma unroll
        for (int j = 0; j < 4; ++j) { const int k = 256 * j + 4 * lane; *(f32x4*)(x + k) = *(const f32x4*)(x + k) * rstd * (*(const f32x4*)(fw + k)); }
    }
}

typedef const __attribute__((address_space(4))) Args* KArgs;
__device__ __forceinline__ KArgs fresh_args() { unsigned long long p = (unsigned long long)__builtin_amdgcn_kernarg_segment_ptr(); asm volatile("" : "+s"(p)); return (KArgs)p; }
#define WSP(T, off) ((T*)(ws + (off)))

__global__ void __launch_bounds__(NWAVES * 64, 2) mk_fwd(Args a_unused) {
    extern __shared__ __attribute__((aligned(16))) unsigned char lds_raw[];
    LAS unsigned char* lds = (LAS unsigned char*)lds_raw;
    const int G = gridDim.x, bx = blockIdx.x;
    { const int tid = threadIdx.x; for (int u = tid; u < (LDS_BYTES - RING_BYTES) / 4; u += NWAVES * 64) ((LAS unsigned*)(lds + RING_BYTES))[u] = 0u; }
    __syncthreads();
    XcdBarrier bar;
    { unsigned char* ws = fresh_args()->ws; bar = xcd_barrier_post((unsigned*)(ws + WS_CTL) + 4096, (volatile LAS unsigned*)(lds + MISC_OFF) + 8); }

    { KArgs A = fresh_args(); unsigned char* ws = A->ws; int tid_o = threadIdx.x; asm volatile("" : "+v"(tid_o)); const int tid = tid_o, lane = tid & 63, wave = __builtin_amdgcn_readfirstlane(tid >> 6), gw = bx * NWAVES + wave, ngw = G * NWAVES;
      LAS float* scr = (LAS float*)(lds + wave * 16384);
      p0a_mod(A->in[1], A->in[3], A->in[4], A->in[5], WSP(float, WS_MOD), scr, gw, ngw, lane);
      if (bx == G - 1) p0a_rope(WSP(float, WS_ROPE), tid);
      p0a_convert(A, scr, gw, ngw, lane); }
    xcd_barrier(bar);
    { KArgs A = fresh_args(); unsigned char* ws = A->ws; int tid_o = threadIdx.x; asm volatile("" : "+v"(tid_o)); const int tid = tid_o, lane = tid & 63, wave = __builtin_amdgcn_readfirstlane(tid >> 6), gw = bx * NWAVES + wave, ngw = G * NWAVES;
      p0b_rows(A->in[0], A->in[2], A->out, WSP(float, WS_XC), A->in[6], WSP(float, WS_MOD), WSP(bf16, WS_XT), WSP(float, WS_SSQ), gw, ngw, lane);
      p0b_sw(ws, WSP(float, WS_MOD), WSP(float, WS_SW), gw, ngw, lane); }
    xcd_barrier(bar);

    for (int l = 0; l < DEPTH; ++l) {
        const bool last = l == DEPTH - 1;
        const int Mrows = last ? ML : R;
        for (int f = 0; f < 2; ++f) {
            const int Mf = (f == 1) ? Mrows : R;
            { KArgs A = fresh_args(); unsigned char* ws = A->ws; const unsigned char* wl = ws + WS_W + (size_t)l * W_LAYER; int bxo = bx; asm volatile("" : "+s"(bxo));
              pg8::Gemm g{WSP(bf16, WS_XT), (const bf16*)(wl + (f ? W_WI2 : W_WI1)), Mf, 2 * DFF, D}; pg8::StaticOrder S; S.init(Mf, 2 * DFF, G, bxo);
              pg8::EpiSwigluF E{WSP(bf16, WS_U + U_ACT), WSP(float, WS_SSQ), WSP(float, WS_SW) + (size_t)(l * 9 + (f ? 6 : 0)) * SWN};
              pg8::gemm_phase<pg8::EpiSwigluF, pg8::StaticOrder, true, true>(lds, g, S, E); }
            xcd_barrier(bar);
            { KArgs A = fresh_args(); unsigned char* ws = A->ws; const unsigned char* wl = ws + WS_W + (size_t)l * W_LAYER; int bxo = bx; asm volatile("" : "+s"(bxo)); const float* modl = WSP(float, WS_MOD) + (size_t)l * 3 * MODS; const float* nw = A->in[6] + l * 3 * D;
              pg8::Gemm g{WSP(bf16, WS_U + U_ACT), (const bf16*)(wl + (f ? W_WO2 : W_WO1)), Mf, D, DFF}; pg8::StaticOrder S; S.init(Mf, D, G, bxo);
              const float* nwn; const float* scn;
              if (f == 0) { nwn = nw + D; scn = modl + 4 * D; } else if (!last) { nwn = nw + 3 * D; scn = modl + 3 * MODS + 1 * D; } else { nwn = nw; scn = modl; }
              pg8::EpiResidF<1> E{A->out, WSP(float, WS_XC), modl + (f ? 8 : 2) * D, nwn, scn, WSP(bf16, WS_XT), WSP(float, WS_SSQ)};
              pg8::gemm_phase<pg8::EpiResidF<1>, pg8::StaticOrder, true, true>(lds, g, S, E); }
            xcd_barrier(bar);
            if (f == 1) break;
            { KArgs A = fresh_args(); unsigned char* ws = A->ws; const unsigned char* wl = ws + WS_W + (size_t)l * W_LAYER; int bxo = bx; asm volatile("" : "+s"(bxo)); unsigned char* U = ws + WS_U;
              pg8::Gemm g{WSP(bf16, WS_XT), (const bf16*)(wl + W_WIN), R, PROJ_W, D}; pg8::StaticOrder S; S.init(R, PROJ_W, G, bxo);
              pg8::EpiWinF E{(bf16*)(U + U_Q), (bf16*)(U + U_K), (bf16*)(U + U_V), (bf16*)(U + U_ZB), (bf16*)(U + U_P), (bf16*)(U + U_SGA), (bf16*)(U + U_SGB), WSP(float, WS_ROPE), WSP(float, WS_SSQ), WSP(float, WS_SW) + (size_t)(l * 9 + 3) * SWN};
              pg8::gemm_phase<pg8::EpiWinF, pg8::StaticOrder, true, true>(lds, g, S, E); }
            xcd_barrier(bar);
            { KArgs A = fresh_args(); unsigned char* ws = A->ws; unsigned char* U = ws + WS_U; int tid_o = threadIdx.x; asm volatile("" : "+v"(tid_o)); const int tid = tid_o, lane = tid & 63, wave = __builtin_amdgcn_readfirstlane(tid >> 6);
              attn_phase(lds, (const bf16*)(U + U_Q), (const bf16*)(U + U_K), (const bf16*)(U + U_V), A->in[11] + l * NH, (bf16*)(U + U_OY), !last, G, bx, tid);
              conv_phase((const bf16*)(U + U_ZB), (const bf16*)(U + U_P), A->in[10] + l * 3 * 512, (bf16*)(U + U_OY), Mrows, bx * NWAVES * 64 + tid, G * NWAVES * 64); }
            xcd_barrier(bar);
            { KArgs A = fresh_args(); unsigned char* ws = A->ws; const unsigned char* wl = ws + WS_W + (size_t)l * W_LAYER; int bxo = bx; asm volatile("" : "+s"(bxo)); unsigned char* U = ws + WS_U;
              pg8::Gemm g{(const bf16*)(U + U_OY), (const bf16*)(wl + W_WM), Mrows, D, D}; pg8::StaticOrder S; S.init(Mrows, D, G, bxo);
              pg8::EpiMergeF E{(const bf16*)(U + U_SGA), (const bf16*)(U + U_SGB), (bf16*)(U + U_M)};
              pg8::gemm_phase<pg8::EpiMergeF, pg8::StaticOrder, true, true>(lds, g, S, E); }
            xcd_barrier(bar);
            { KArgs A = fresh_args(); unsigned char* ws = A->ws; const unsigned char* wl = ws + WS_W + (size_t)l * W_LAYER; int bxo = bx; asm volatile("" : "+s"(bxo)); const float* modl = WSP(float, WS_MOD) + (size_t)l * 3 * MODS; const float* nw = A->in[6] + l * 3 * D;
              pg8::Gemm g{WSP(bf16, WS_U + U_M), (const bf16*)(wl + W_WOUT), Mrows, D, D}; pg8::StaticOrder S; S.init(Mrows, D, G, bxo);
              pg8::EpiResidF<2> E{A->out, WSP(float, WS_XC), modl + 5 * D, nw + 2 * D, modl + 7 * D, WSP(bf16, WS_XT), WSP(float, WS_SSQ)};
              pg8::gemm_phase<pg8::EpiResidF<2>, pg8::StaticOrder, true, true>(lds, g, S, E); }
            xcd_barrier(bar);
        }
    }
    { KArgs A = fresh_args(); unsigned char* ws = A->ws; int tid_o = threadIdx.x; asm volatile("" : "+v"(tid_o)); const int tid = tid_o, lane = tid & 63, wave = __builtin_amdgcn_readfirstlane(tid >> 6);
      final_phase(A->out, WSP(float, WS_SSQ), A->in[17], bx * NWAVES + wave, G * NWAVES, lane); }
}

extern "C" void kernel_launch(void* const* d_in, const int* in_sizes, int n_in, void* d_out, int out_size, void* d_ws, size_t ws_size, hipStream_t stream) {
    static int grid = 0;
    if (grid == 0) {
        if (n_in != 18 || in_sizes[0] != ML * D || out_size != ML * D || ws_size < WS_END) { fprintf(stderr, "kernel_launch: unexpected shapes (n_in %d, in0 %d, out %d, ws %zu < %zu); nothing launched\n", n_in, n_in > 0 ? in_sizes[0] : -1, out_size, ws_size, (size_t)WS_END); grid = -1; return; }
        int dev = 0, cus = 0, per_cu = 0;
        if (hipGetDevice(&dev) != hipSuccess || hipDeviceGetAttribute(&cus, hipDeviceAttributeMultiprocessorCount, dev) != hipSuccess) { fprintf(stderr, "kernel_launch: device query failed\n"); grid = -1; return; }
        if (hipFuncSetAttribute((const void*)mk_fwd, hipFuncAttributeMaxDynamicSharedMemorySize, LDS_BYTES) != hipSuccess) { fprintf(stderr, "kernel_launch: hipFuncSetAttribute failed\n"); grid = -1; return; }
        if (hipOccupancyMaxActiveBlocksPerMultiprocessor(&per_cu, (const void*)mk_fwd, NWAVES * 64, LDS_BYTES) != hipSuccess || per_cu < 1) { fprintf(stderr, "kernel_launch: occupancy query says %d blocks per CU; nothing launched\n", per_cu); (void)hipGetLastError(); grid = -1; return; }
        grid = cus;
    }
    if (grid < 0) return;
    (void)hipMemsetAsync((char*)d_ws, 0, ZERO_BYTES, stream);
    Args a{};
    for (int i = 0; i < 18; ++i) a.in[i] = (const float*)d_in[i];
    a.out = (float*)d_out; a.ws = (unsigned char*)d_ws;
    hipLaunchKernelGGL(mk_fwd, dim3(grid), dim3(NWAVES * 64), LDS_BYTES, stream, a);
}
```
